# Optimizing an MI355X kernel written in HIP

```python
import math
import jax
import jax.numpy as jnp
from jax import lax
import numpy as np

D_MODEL = 1024
BATCH = 2
SEQ = 16384
DEPTH = 2
DEC_BATCH = 8
DEC_SEQ = 16
PAST_LEN = 1024

CHUNK = 64
WINDOW = 128
N_WIN_CHUNKS = WINDOW // CHUNK
HEAD_DIM = 64
N_Q_HEADS = 8
N_KV_HEADS = 2
GROUP = N_Q_HEADS // N_KV_HEADS
ATTN_WIDTH = N_Q_HEADS * HEAD_DIM
KV_WIDTH = N_KV_HEADS * HEAD_DIM
POOL_WINDOWS = (2, 4, 8, 16)
N_POOL_GROUPS = 4
POOL_WIDTH = 512
POOL_GROUP_DIM = POOL_WIDTH // N_POOL_GROUPS
POOL_MAXW = max(POOL_WINDOWS)
POOL_HIST = POOL_MAXW - 1
N_BRANCHES = 2
IN_WIDTH = ATTN_WIDTH + 2 * KV_WIDTH + POOL_WIDTH + N_BRANCHES * D_MODEL
D_FF = 2816
CONV_WIDTH = 3
CONV_HIST = CONV_WIDTH - 1
EPS = 1e-6
NEG_INF = -1e30

kernel_name = "hybrid_streaming_swa_pool_convffn_step"


def rms_norm(x, g):
    xf = x.astype(jnp.float32)
    y = xf * lax.rsqrt(jnp.mean(xf * xf, axis=-1, keepdims=True) + EPS)
    return (y * g.astype(jnp.float32)).astype(x.dtype)


def alibi_slopes():
    return jnp.asarray([2.0 ** (-8.0 * (h + 1) / N_Q_HEADS) for h in range(N_Q_HEADS)], dtype=jnp.float32)


def alibi_bias(rel):
    b = -alibi_slopes()[:, None, None] * jnp.abs(rel).astype(jnp.float32)[None]
    return b.reshape(N_KV_HEADS, GROUP, rel.shape[0], rel.shape[1])


def sink_softmax_apply(scores, sinks_b, v, eq):
    m = jnp.maximum(scores.max(-1), sinks_b)
    p = jnp.exp(scores - m[..., None])
    denom = p.sum(-1) + jnp.exp(sinks_b - m)
    p = p / denom[..., None]
    return jnp.einsum(eq, p.astype(v.dtype), v)


def swa_prompt(q, k, v, sinks):
    B, S = q.shape[0], q.shape[1]
    n_c = S // CHUNK
    kb_len = (N_WIN_CHUNKS + 1) * CHUNK
    qc = q.reshape(B, n_c, CHUNK, N_KV_HEADS, GROUP, HEAD_DIM)
    pad = ((0, 0), (WINDOW, 0), (0, 0), (0, 0))
    kp = jnp.pad(k, pad).reshape(B, n_c + N_WIN_CHUNKS, CHUNK, N_KV_HEADS, HEAD_DIM)
    vp = jnp.pad(v, pad).reshape(B, n_c + N_WIN_CHUNKS, CHUNK, N_KV_HEADS, HEAD_DIM)
    kb = jnp.concatenate([kp[:, j:j + n_c] for j in range(N_WIN_CHUNKS + 1)], axis=2)
    vb = jnp.concatenate([vp[:, j:j + n_c] for j in range(N_WIN_CHUNKS + 1)], axis=2)
    scores = jnp.einsum('bcqkgd,bcskd->bckgqs', qc, kb).astype(jnp.float32) * (HEAD_DIM ** -0.5)
    rel = WINDOW + jnp.arange(CHUNK)[:, None] - jnp.arange(kb_len)[None, :]
    key_pos = jnp.arange(n_c)[:, None] * CHUNK - WINDOW + jnp.arange(kb_len)[None, :]
    valid = key_pos >= 0
    scores = jnp.where(valid[None, :, None, None, None, :], scores + alibi_bias(rel), NEG_INF)
    sk = sinks.astype(jnp.float32).reshape(N_KV_HEADS, GROUP, 1)
    out = sink_softmax_apply(scores, sk, vb, 'bckgqs,bcskd->bcqkgd')
    return out.reshape(B, S, ATTN_WIDTH)


def swa_sample(q, k_new, v_new, cache_k, cache_v, sinks):
    B, T = q.shape[0], q.shape[1]
    kk = jnp.concatenate([cache_k, k_new.astype(cache_k.dtype)], axis=1)
    vv = jnp.concatenate([cache_v, v_new.astype(cache_v.dtype)], axis=1)
    qg = q.reshape(B, T, N_KV_HEADS, GROUP, HEAD_DIM)
    scores = jnp.einsum('btkgd,bskd->bkgts', qg, kk).astype(jnp.float32) * (HEAD_DIM ** -0.5)
    rel = WINDOW + jnp.arange(T)[:, None] - jnp.arange(WINDOW + T)[None, :]
    scores = scores + alibi_bias(rel)
    sk = sinks.astype(jnp.float32).reshape(N_KV_HEADS, GROUP, 1)
    out = sink_softmax_apply(scores, sk, vv, 'bkgts,bskd->btkgd')
    return out.reshape(B, T, ATTN_WIDTH), kk[:, -WINDOW:], vv[:, -WINDOW:]


def pool_mixer(p_ext, pos, w_pool, pool_scale):
    B, L, C = p_ext.shape
    T = L - POOL_HIST
    f = p_ext.astype(jnp.float32)
    cs = jnp.cumsum(f, axis=1)
    cs_pad = jnp.pad(cs, ((0, 0), (POOL_MAXW, 0), (0, 0)))
    means = []
    for g, w in enumerate(POOL_WINDOWS):
        lo, hi = g * POOL_GROUP_DIM, (g + 1) * POOL_GROUP_DIM
        win = cs[:, POOL_HIST:, lo:hi] - cs_pad[:, POOL_MAXW - w + POOL_HIST:POOL_MAXW - w + L, lo:hi]
        cnt = jnp.minimum(pos + 1, w).astype(jnp.float32)[None, :, None]
        means.append(win / cnt)
    d = (jnp.concatenate(means, axis=-1) - f[:, POOL_HIST:]).reshape(B, T, N_POOL_GROUPS, POOL_GROUP_DIM)
    y = jnp.einsum('btgc,gcd->btgd', d, w_pool.astype(jnp.float32)).reshape(B, T, C)
    y = y * pool_scale.astype(jnp.float32)
    return y.astype(p_ext.dtype)


def conv_ffn(xn, conv_hist, w_up, conv_w, conv_b, w_down):
    h = xn @ w_up
    T = h.shape[1]
    h_ext = jnp.concatenate([conv_hist.astype(h.dtype), h], axis=1)
    hc = conv_b
    for j in range(CONV_WIDTH):
        hc = hc + conv_w[j] * h_ext[:, j:j + T]
    gate, val = jnp.split(hc, 2, axis=-1)
    y = (jax.nn.gelu(gate, approximate=False) * val) @ w_down
    return y, h_ext[:, -CONV_HIST:]


def trunk_layer(x, pos, kv_cache, pool_hist, conv_hist, lp):
    B, T = x.shape[0], x.shape[1]
    xn = rms_norm(x, lp['norm_mix'])
    proj = xn @ lp['w_in']
    cuts = [ATTN_WIDTH, ATTN_WIDTH + KV_WIDTH, ATTN_WIDTH + 2 * KV_WIDTH, ATTN_WIDTH + 2 * KV_WIDTH + POOL_WIDTH]
    q, k, v, pin, gates = jnp.split(proj, cuts, axis=-1)
    q = rms_norm(q.reshape(B, T, N_Q_HEADS, HEAD_DIM), lp['q_norm'])
    k = rms_norm(k.reshape(B, T, N_KV_HEADS, HEAD_DIM), lp['k_norm'])
    v = v.reshape(B, T, N_KV_HEADS, HEAD_DIM)
    if kv_cache is None:
        a = swa_prompt(q, k, v, lp['sinks'])
        k_state, v_state = k[:, -WINDOW:], v[:, -WINDOW:]
    else:
        a, k_state, v_state = swa_sample(q, k, v, kv_cache[0], kv_cache[1], lp['sinks'])
    p_ext = jnp.concatenate([pool_hist.astype(pin.dtype), pin], axis=1)
    pl = pool_mixer(p_ext, pos, lp['w_pool'], lp['pool_scale'])
    pool_state = p_ext[:, -POOL_HIST:]
    ya = a @ lp['w_br_attn']
    yb = pl @ lp['w_br_pool']
    g = jax.nn.sigmoid(gates.reshape(B, T, N_BRANCHES, D_MODEL) + lp['gate_bias'])
    mix = (g[:, :, 0] * ya + g[:, :, 1] * yb) @ lp['w_out']
    x = x + mix
    y, conv_state = conv_ffn(rms_norm(x, lp['norm_ffn']), conv_hist, lp['w_up'], lp['conv_w'], lp['conv_b'], lp['w_down'])
    x = x + y
    return x, k_state, v_state, pool_state, conv_state


def setup_inputs(seed: int = 0) -> dict:
    key = jax.random.key(seed)
    ks = jax.random.split(key, 24)

    def nrm(k, shape, scale):
        return jax.random.normal(k, shape, jnp.float32) * scale

    return {
        'x_prompt': nrm(ks[0], (BATCH, SEQ, D_MODEL), 1.0),
        'x_sample': nrm(ks[1], (DEC_BATCH, DEC_SEQ, D_MODEL), 1.0),
        'cache_k': nrm(ks[2], (DEPTH, DEC_BATCH, WINDOW, N_KV_HEADS, HEAD_DIM), 1.0),
        'cache_v': nrm(ks[3], (DEPTH, DEC_BATCH, WINDOW, N_KV_HEADS, HEAD_DIM), 1.0),
        'state_pool': nrm(ks[4], (DEPTH, DEC_BATCH, POOL_HIST, POOL_WIDTH), 1.0),
        'state_conv': nrm(ks[5], (DEPTH, DEC_BATCH, CONV_HIST, 2 * D_FF), 1.0),
        'norm_mix': 1.0 + nrm(ks[6], (DEPTH, D_MODEL), 0.05),
        'w_in': nrm(ks[7], (DEPTH, D_MODEL, IN_WIDTH), D_MODEL ** -0.5),
        'q_norm': 1.0 + nrm(ks[8], (DEPTH, HEAD_DIM), 0.05),
        'k_norm': 1.0 + nrm(ks[9], (DEPTH, HEAD_DIM), 0.05),
        'sinks': nrm(ks[10], (DEPTH, N_Q_HEADS), 1.0),
        'w_pool': nrm(ks[11], (DEPTH, N_POOL_GROUPS, POOL_GROUP_DIM, POOL_GROUP_DIM), POOL_GROUP_DIM ** -0.5),
        'pool_scale': 1.0 + nrm(ks[12], (DEPTH, POOL_WIDTH), 0.05),
        'w_br_attn': nrm(ks[13], (DEPTH, ATTN_WIDTH, D_MODEL), ATTN_WIDTH ** -0.5),
        'w_br_pool': nrm(ks[14], (DEPTH, POOL_WIDTH, D_MODEL), POOL_WIDTH ** -0.5),
        'gate_bias': nrm(ks[15], (DEPTH, N_BRANCHES, D_MODEL), 0.01),
        'w_out': nrm(ks[16], (DEPTH, D_MODEL, D_MODEL), D_MODEL ** -0.5),
        'norm_ffn': 1.0 + nrm(ks[17], (DEPTH, D_MODEL), 0.05),
        'w_up': nrm(ks[18], (DEPTH, D_MODEL, 2 * D_FF), D_MODEL ** -0.5),
        'conv_w': nrm(ks[19], (DEPTH, CONV_WIDTH, 2 * D_FF), CONV_WIDTH ** -0.5),
        'conv_b': nrm(ks[20], (DEPTH, 2 * D_FF), 0.01),
        'w_down': nrm(ks[21], (DEPTH, D_FF, D_MODEL), D_FF ** -0.5),
    }


def reference(x_prompt, x_sample, cache_k, cache_v, state_pool, state_conv,
              norm_mix, w_in, q_norm, k_norm, sinks, w_pool, pool_scale,
              w_br_attn, w_br_pool, gate_bias, w_out, norm_ffn, w_up, conv_w, conv_b, w_down):
    B, S = x_prompt.shape[0], x_prompt.shape[1]
    DB, T = x_sample.shape[0], x_sample.shape[1]
    pos_p = jnp.arange(S)
    pos_s = PAST_LEN + jnp.arange(T)
    zero_pool = jnp.zeros((B, POOL_HIST, POOL_WIDTH), x_prompt.dtype)
    zero_conv = jnp.zeros((B, CONV_HIST, 2 * D_FF), x_prompt.dtype)
    xp, xs = x_prompt, x_sample
    kp_l, vp_l, pp_l, cp_l = [], [], [], []
    ks_l, vs_l, ps_l, cs_l = [], [], [], []
    for l in range(DEPTH):
        lp = {
            'norm_mix': norm_mix[l], 'w_in': w_in[l], 'q_norm': q_norm[l], 'k_norm': k_norm[l],
            'sinks': sinks[l], 'w_pool': w_pool[l], 'pool_scale': pool_scale[l],
            'w_br_attn': w_br_attn[l], 'w_br_pool': w_br_pool[l], 'gate_bias': gate_bias[l],
            'w_out': w_out[l], 'norm_ffn': norm_ffn[l], 'w_up': w_up[l], 'conv_w': conv_w[l],
            'conv_b': conv_b[l], 'w_down': w_down[l],
        }
        xp, kp, vp, pp, cp = trunk_layer(xp, pos_p, None, zero_pool, zero_conv, lp)
        xs, ks_, vs_, ps_, cs_ = trunk_layer(xs, pos_s, (cache_k[l], cache_v[l]), state_pool[l], state_conv[l], lp)
        kp_l.append(kp); vp_l.append(vp); pp_l.append(pp); cp_l.append(cp)
        ks_l.append(ks_); vs_l.append(vs_); ps_l.append(ps_); cs_l.append(cs_)
    k_prompt = jnp.stack(kp_l, axis=0)
    v_prompt = jnp.stack(vp_l, axis=0)
    pool_prompt = jnp.stack(pp_l, axis=0)
    conv_prompt = jnp.stack(cp_l, axis=0)
    k_sample = jnp.stack(ks_l, axis=0)
    v_sample = jnp.stack(vs_l, axis=0)
    pool_sample = jnp.stack(ps_l, axis=0)
    conv_sample = jnp.stack(cs_l, axis=0)
    return (xp, xs, k_prompt, v_prompt, pool_prompt, conv_prompt, k_sample, v_sample, pool_sample, conv_sample)
```

```cpp
#include <hip/hip_runtime.h>
#include <hip/hip_cooperative_groups.h>
#include <cstdio>
#include <cstdint>
namespace cg = cooperative_groups;

#define LAS __attribute__((address_space(3)))
typedef unsigned short bf16_t;
typedef short bf16x8 __attribute__((ext_vector_type(8)));
typedef float f32x4 __attribute__((ext_vector_type(4)));
typedef float f32x2 __attribute__((ext_vector_type(2)));
typedef float f32x16 __attribute__((ext_vector_type(16)));
typedef unsigned u32x4 __attribute__((ext_vector_type(4)));
typedef unsigned u32x2 __attribute__((ext_vector_type(2)));

constexpr int DM = 1024, SEQ = 16384, NB = 2, MP = NB * SEQ, MS = 128, MREAL = MP + MS, MPAD = 33024;
constexpr int INW = 3328, FF = 2816, FF2 = 5632;
constexpr float EPS = 1e-6f, LOG2E = 1.4426950408889634f;
constexpr size_t O_Y = 0, O_KP = 33685504, O_VP = 33751040, O_PP = 33816576, O_CP = 33847296, O_KS = 33892352, O_VS = 34154496, O_PS = 34416640, O_CS = 34539520;
constexpr size_t MiB = 1u << 20;
constexpr size_t WS_SSQ = 0;
constexpr size_t WS_BAR = 768 * 1024;
constexpr int MISC_OFF = 147456 - 64;
constexpr size_t WS_W = 1 * MiB, W_LAYER = 27 * MiB;
constexpr size_t WO_IN = 0, WO_MIX = 6 * MiB + 512 * 1024, WO_OUT = WO_MIX + 2 * MiB, WO_UP = WO_OUT + 2 * MiB, WO_DOWN = WO_UP + 11 * MiB;
constexpr size_t WS_XB = 56 * MiB, WS_AD = 121 * MiB, WS_MIX = 186 * MiB, WS_PROJ = 251 * MiB;
constexpr size_t WS_HALO = 462 * MiB;
constexpr int LDS_BYTES = 147456, XCH_OFF = 131072;
#ifndef REP_P0
#define REP_P0 1
#endif
#ifndef REP_P1
#define REP_P1 1
#endif
#ifndef REP_P2
#define REP_P2 1
#endif
#ifndef REP_P3
#define REP_P3 1
#endif
#ifndef REP_P5
#define REP_P5 1
#endif
#ifndef DRY_P6
#define DRY_P6 0
#endif
#ifndef EXTRA_SYNC
#define EXTRA_SYNC 0
#endif

struct Params {
    const float *xp, *xs, *cache_k, *cache_v, *state_pool, *state_conv, *norm_mix, *w_in, *q_norm, *k_norm, *sinks, *w_pool, *pool_scale,
        *w_br_attn, *w_br_pool, *gate_bias, *w_out, *norm_ffn, *w_up, *conv_w, *conv_b, *w_down;
    float* out; unsigned char* ws;
};

__device__ __forceinline__ unsigned cvt_pk_bf16(float lo, float hi) { unsigned r; asm volatile("v_cvt_pk_bf16_f32 %0, %1, %2" : "=v"(r) : "v"(lo), "v"(hi)); return r; }
__device__ __forceinline__ float bf_lo(unsigned u) { return __builtin_bit_cast(float, u << 16); }
__device__ __forceinline__ float bf_hi(unsigned u) { return __builtin_bit_cast(float, u & 0xffff0000u); }
__device__ __forceinline__ void unpack8(const u32x4 w, float* f) { f[0] = bf_lo(w.x); f[1] = bf_hi(w.x); f[2] = bf_lo(w.y); f[3] = bf_hi(w.y); f[4] = bf_lo(w.z); f[5] = bf_hi(w.z); f[6] = bf_lo(w.w); f[7] = bf_hi(w.w); }
__device__ __forceinline__ u32x4 pack8(const float* f) { u32x4 w; w.x = cvt_pk_bf16(f[0], f[1]); w.y = cvt_pk_bf16(f[2], f[3]); w.z = cvt_pk_bf16(f[4], f[5]); w.w = cvt_pk_bf16(f[6], f[7]); return w; }
__device__ __forceinline__ float ror1(float x) { return __builtin_bit_cast(float, __builtin_amdgcn_update_dpp(0, __builtin_bit_cast(int, x), 0x121, 0xf, 0xf, false)); }
__device__ __forceinline__ float ror2(float x) { return __builtin_bit_cast(float, __builtin_amdgcn_update_dpp(0, __builtin_bit_cast(int, x), 0x122, 0xf, 0xf, false)); }
__device__ __forceinline__ f32x2 gelu_pk(f32x2 v) {
    const f32x2 av = __builtin_elementwise_abs(v), d = av * 0.2316418882f + 1.0f;
    f32x2 t; t.x = __builtin_amdgcn_rcpf(d.x); t.y = __builtin_amdgcn_rcpf(d.y);
    f32x2 q = t * 0.5307027145f + (-0.7265760135f); q = q * t + 0.7107068705f; q = q * t + (-0.142248368f); q = q * t + 0.127414796f; q = q * t;
    const f32x2 s = (v * v) * (-0.72134752044f);
    f32x2 e; e.x = __builtin_amdgcn_exp2f(s.x); e.y = __builtin_amdgcn_exp2f(s.y);
    const f32x2 m = v * (q * e), r = v - m;
    f32x2 o; o.x = v.x < 0.f ? m.x : r.x; o.y = v.y < 0.f ? m.y : r.y; return o;
}

namespace pg8 {
constexpr int BM = 256, BK = 64, HALF = 128, HTB = HALF * BK * 2, STAGE_BYTES = 8 * HTB, NXCD = 8, WGM = 8;
__host__ __device__ __forceinline__ int lds_byte(int r, int c) { const int st = (r >> 4) * 2 + (c >> 5), rr = r & 15, cc = c & 31, ob = rr * 64 + cc * 2; return st * 1024 + (ob ^ (((ob >> 9) & 1) << 5)); }
__host__ __device__ __forceinline__ void stage_rc(int b, int& R, int& C) { const int st = b / 1024, sb = b % 1024, swz = sb ^ (((sb >> 9) & 1) << 5); R = (st >> 1) * 16 + swz / 64; C = (st & 1) * 32 + (swz % 64) / 2; }
__host__ __device__ __forceinline__ int perm32(int rho) { const int n = rho >> 4, i = rho & 15; return 8 * (i >> 2) + 4 * n + (i & 3); }

struct Unit { int pm, pn, z; };
struct Gemm { const bf16_t* A; const bf16_t* Bt; int lda, ldb, K; };

struct TileOrder {
    int nM, nN, nwg, G, c;
    __device__ void init(int nM_, int nN_, int G_, int c_) { nM = nM_; nN = nN_; nwg = nM * nN; G = G_; c = c_; }
    __device__ bool tile(int i, Unit& u) const {
        const long L = (long)i * G + c; if (L >= nwg) return false;
        int wgid = (int)L; { const int q = nwg / NXCD, r = nwg % NXCD, xcd = wgid % NXCD, off = wgid / NXCD; wgid = (xcd < r ? xcd * (q + 1) : r * (q + 1) + (xcd - r) * q) + off; }
        const int nig = WGM * nN, gid = wgid / nig, fm = gid * WGM, gsz = (nM - fm) < WGM ? (nM - fm) : WGM;
        u.pm = fm + ((wgid % nig) % gsz); u.pn = (wgid % nig) / gsz; return true;
    }
};

template <class E> __device__ __forceinline__ auto epi_keep_acc(const E& e, const Unit& u) -> decltype(e.keep_acc(u)) { return e.keep_acc(u); }
__device__ __forceinline__ bool epi_keep_acc(...) { return false; }
template <class Epi, class Sched>
__device__ __forceinline__ void gemm_phase(LAS unsigned char* lds, const Gemm g, const Sched& S, const Epi& E) {
    int tid = threadIdx.x; asm volatile("" : "+v"(tid));
    const int wid = __builtin_amdgcn_readfirstlane(tid >> 6), lane = tid & 63, wr = wid >> 2, wc = wid & 3, fr = lane & 15, fq = lane >> 4;
    const int K = g.K, nt = K / BK;
    unsigned voffA[2], voffB[2];
#pragma unroll
    for (int i = 0; i < 2; ++i) { int R, C; stage_rc(tid * 16 + i * 8192, R, C); const int Rb = Epi::PERM ? ((R & ~31) + perm32(R & 31)) : R;
        voffA[i] = (unsigned)(R * g.lda + C) * 2u; voffB[i] = (unsigned)(Rb * g.ldb + C) * 2u; }
    const size_t kstep = (size_t)(BK * 2);
    const size_t hstepA = (size_t)HALF * g.lda * 2, hstepB = (size_t)HALF * g.ldb * 2;
    const unsigned ldsw = (unsigned)wid * 1024u;
    const int aoff = lds_byte(wr * 64 + fr, fq * 8), boff = lds_byte(wc * 32 + fr, fq * 8);
#define PG8_SA(b, h) (((b) * 2 + (h)) * HTB)
#define PG8_SB(b, h) ((4 + (b) * 2 + (h)) * HTB)
#define PG8_STAGE(bufoff, gbase, voff) do { _Pragma("unroll") for (int _i = 0; _i < 2; ++_i) \
        __builtin_amdgcn_global_load_lds((const unsigned*)((const char*)(gbase) + (voff)[_i]), (LAS unsigned*)(lds + (bufoff) + ldsw + _i * 8192), 16, 0, 0); } while (0)
#define PG8_LDA(dst, b, h) do { _Pragma("unroll") for (int m = 0; m < 4; ++m) _Pragma("unroll") for (int k = 0; k < 2; ++k) dst[m][k] = *(const LAS bf16x8*)(lds + PG8_SA(b, h) + aoff + m * 2048 + k * 1024); } while (0)
#define PG8_LDB(dst, b, h) do { _Pragma("unroll") for (int n = 0; n < 2; ++n) _Pragma("unroll") for (int k = 0; k < 2; ++k) dst[n][k] = *(const LAS bf16x8*)(lds + PG8_SB(b, h) + boff + n * 2048 + k * 1024); } while (0)
#define PG8_MMA(ai, bj, At, Bt) do { __builtin_amdgcn_s_setprio(1); _Pragma("unroll") for (int m = 0; m < 4; ++m) _Pragma("unroll") for (int n = 0; n < 2; ++n) _Pragma("unroll") for (int k = 0; k < 2; ++k) \
        acc[ai][bj][m][n] = __builtin_amdgcn_mfma_f32_16x16x32_bf16(Bt[n][k], At[m][k], acc[ai][bj][m][n], 0, 0, 0); __builtin_amdgcn_s_setprio(0); } while (0)
#define PG8_WAIT_V(n) asm volatile("s_waitcnt vmcnt(" #n ")" ::: "memory")
#define PG8_WAIT_L(n) asm volatile("s_waitcnt lgkmcnt(" #n ")" ::: "memory")
#define PG8_BAR __builtin_amdgcn_s_barrier()
#define PG8_SCHED __builtin_amdgcn_sched_barrier(0)
    Unit cur, nxt; int ui = 0;
    if (!S.next(0, cur)) return;
    f32x4 acc[2][2][4][2];
#pragma unroll
    for (int a = 0; a < 2; ++a)
#pragma unroll
        for (int b = 0; b < 2; ++b)
#pragma unroll
            for (int m = 0; m < 4; ++m)
#pragma unroll
                for (int n = 0; n < 2; ++n) acc[a][b][m][n] = (f32x4){0.f, 0.f, 0.f, 0.f};
    bf16x8 At[4][2], B0[2][2], B1[2][2];
    const char* cA = (const char*)g.A + S.a_off(cur); const char* cB = (const char*)g.Bt + S.b_off(cur);
    PG8_STAGE(PG8_SB(0, 0), cB, voffB); PG8_STAGE(PG8_SB(0, 1), cB + hstepB, voffB); PG8_STAGE(PG8_SA(0, 0), cA, voffA); PG8_STAGE(PG8_SA(0, 1), cA + hstepA, voffA);
    if (wr == 1) PG8_BAR;
    PG8_WAIT_V(2); PG8_BAR;
    PG8_STAGE(PG8_SB(1, 0), cB + kstep, voffB); PG8_STAGE(PG8_SA(1, 0), cA + kstep, voffA); PG8_STAGE(PG8_SB(1, 1), cB + hstepB + kstep, voffB);
    PG8_WAIT_V(6); PG8_BAR;
    for (;;) {
        const bool has_next = S.next(ui + 1, nxt);
        const char* nA = has_next ? (const char*)g.A + S.a_off(nxt) : cA; const char* nB = has_next ? (const char*)g.Bt + S.b_off(nxt) : cB;
        for (int t = 0; t < nt; t += 2) {
            const bool last = (t == nt - 2);
            const char* a1 = cA + (size_t)(t + 1) * kstep;
            const char* a2 = last ? nA : cA + (size_t)(t + 2) * kstep; const char* b2 = last ? nB : cB + (size_t)(t + 2) * kstep;
            const char* a3 = a2 + kstep; const char* b3 = b2 + kstep;
            PG8_LDB(B0, 0, 0); PG8_LDB(B1, 0, 1); PG8_SCHED; PG8_LDA(At, 0, 0); PG8_STAGE(PG8_SA(1, 1), a1 + hstepA, voffA);
            PG8_WAIT_V(8); PG8_WAIT_L(0); PG8_BAR; PG8_MMA(0, 0, At, B0); PG8_MMA(0, 1, At, B1); PG8_BAR; PG8_SCHED;
            PG8_LDA(At, 0, 1); PG8_STAGE(PG8_SB(0, 0), b2, voffB); PG8_STAGE(PG8_SB(0, 1), b2 + hstepB, voffB); PG8_STAGE(PG8_SA(0, 0), a2, voffA);
            PG8_WAIT_V(8); PG8_WAIT_L(0); PG8_BAR; PG8_MMA(1, 0, At, B0); PG8_MMA(1, 1, At, B1); PG8_BAR; PG8_SCHED;
            PG8_LDB(B0, 1, 0); PG8_LDB(B1, 1, 1); PG8_SCHED; PG8_LDA(At, 1, 0); PG8_STAGE(PG8_SA(0, 1), a2 + hstepA, voffA);
            PG8_WAIT_V(8); PG8_WAIT_L(0); PG8_BAR; PG8_MMA(0, 0, At, B0); PG8_MMA(0, 1, At, B1); PG8_BAR; PG8_SCHED;
            PG8_LDA(At, 1, 1); PG8_STAGE(PG8_SB(1, 0), b3, voffB); PG8_STAGE(PG8_SB(1, 1), b3 + hstepB, voffB); PG8_STAGE(PG8_SA(1, 0), a3, voffA);
            PG8_WAIT_V(8); PG8_WAIT_L(0); PG8_BAR; PG8_MMA(1, 0, At, B0); PG8_MMA(1, 1, At, B1); PG8_BAR; PG8_SCHED;
        }
        if (wr == 0) PG8_BAR;
        { int fr_ = fr, fq_ = fq; asm volatile("" : "+v"(fr_), "+v"(fq_));
          E(acc, cur, wr, wc, fr_, fq_); }
        if (!has_next) break;
        if (!epi_keep_acc(E, cur)) {
#pragma unroll
        for (int a = 0; a < 2; ++a)
#pragma unroll
            for (int b = 0; b < 2; ++b)
#pragma unroll
                for (int m = 0; m < 4; ++m)
#pragma unroll
                    for (int n = 0; n < 2; ++n) acc[a][b][m][n] = (f32x4){0.f, 0.f, 0.f, 0.f};
        }
        cur = nxt; cA = nA; cB = nB; ++ui;
        if (wr == 1) PG8_BAR;
    }
    PG8_WAIT_V(0);
    PG8_BAR;
#undef PG8_SA
#undef PG8_SB
#undef PG8_STAGE
#undef PG8_LDA
#undef PG8_LDB
#undef PG8_MMA
#undef PG8_WAIT_V
#undef PG8_WAIT_L
#undef PG8_BAR
#undef PG8_SCHED
}
}
using pg8::Unit;
typedef f32x4 AccT[2][2][4][2];

struct SchedPlain {
    pg8::TileOrder o; long tA, tB;
    __device__ __forceinline__ bool next(int i, Unit& u) const { u.z = 0; return o.tile(i, u); }
    __device__ __forceinline__ long a_off(const Unit& u) const { return (long)u.pm * tA; }
    __device__ __forceinline__ long b_off(const Unit& u) const { return (long)u.pn * tB; }
};
struct SchedMix {
    pg8::TileOrder o;
    __device__ __forceinline__ bool next(int i, Unit& u) const { u.z = i & 1; return o.tile(i >> 1, u); }
    __device__ __forceinline__ long a_off(const Unit& u) const { return (long)u.pm * 256 * DM * 2 + (long)u.z * 512 * 2; }
    __device__ __forceinline__ long b_off(const Unit& u) const { return ((long)u.z * 1024 + (long)u.pn * 256) * 512 * 2; }
};
struct SchedUp {
    pg8::TileOrder o;
    __device__ __forceinline__ bool next(int i, Unit& u) const { u.z = 0; return o.tile(i, u); }
    __device__ __forceinline__ long a_off(const Unit& u) const { const int ti = u.pm; const int b = ti / 65, i = ti % 65; return ((long)b * SEQ + 254 * i - 2) * DM * 2; }
    __device__ __forceinline__ long b_off(const Unit& u) const { return (long)u.pn * 256 * DM * 2; }
};

struct EpiProj {
    static constexpr bool PERM = true;
    bf16_t* P; const float* ssq; const float* gbias;
    __device__ __forceinline__ void operator()(AccT& acc, const Unit& u, int wr, int wc, int fr, int fq) const {
        const bool gate = u.pn >= 5;
        const int col0 = u.pn * 256 + wc * 32 + 8 * fq;
        f32x4 gb[2][2];
#pragma unroll
        for (int bj = 0; bj < 2; ++bj)
#pragma unroll
            for (int n = 0; n < 2; ++n) gb[bj][n] = gate ? *(const f32x4*)(gbias + (col0 - 1280) + bj * 128 + 4 * n) : (f32x4){0.f, 0.f, 0.f, 0.f};
        float rsv[2][4];
#pragma unroll
        for (int ai = 0; ai < 2; ++ai)
#pragma unroll
            for (int m = 0; m < 4; ++m) rsv[ai][m] = ssq[u.pm * 256 + ai * 128 + wr * 64 + m * 16 + fr];
#pragma unroll
        for (int ai = 0; ai < 2; ++ai)
#pragma unroll
            for (int m = 0; m < 4; ++m) {
                const int row = u.pm * 256 + ai * 128 + wr * 64 + m * 16 + fr;
                const float rs = __builtin_amdgcn_rsqf(rsv[ai][m] * (1.0f / 1024.0f) + EPS);
                bf16_t* rowp = P + (size_t)row * INW + col0;
#pragma unroll
                for (int bj = 0; bj < 2; ++bj) {
                    float v[8];
#pragma unroll
                    for (int n = 0; n < 2; ++n)
#pragma unroll
                        for (int j = 0; j < 4; ++j) {
                            float x = acc[ai][bj][m][n][j] * rs;
                            if (gate) { x += gb[bj][n][j]; x = __builtin_amdgcn_rcpf(1.0f + __builtin_amdgcn_exp2f(-LOG2E * x)); }
                            v[n * 4 + j] = x;
                        }
                    *(u32x4*)(rowp + bj * 128) = pack8(v);
                }
            }
    }
};
struct EpiMix {
    static constexpr bool PERM = true;
    bf16_t* MIX; const bf16_t* P;
    __device__ __forceinline__ bool keep_acc(const Unit& u) const { return u.z == 0; }
    __device__ __forceinline__ void operator()(AccT& acc, const Unit& u, int wr, int wc, int fr, int fq) const {
        const int col0 = u.pn * 256 + wc * 32 + 8 * fq;
        const char* Pb = (const char*)P;
        u32x4 gw[2][4][2];
        if (u.z == 0) {
#pragma unroll
            for (int ai = 0; ai < 2; ++ai)
#pragma unroll
                for (int m = 0; m < 4; ++m)
#pragma unroll
                    for (int bj = 0; bj < 2; ++bj) gw[ai][m][bj] = *(const u32x4*)(Pb + (unsigned)(((u.pm * 256 + ai * 128 + wr * 64 + m * 16 + fr) * INW + col0 + bj * 128 + 1280) * 2));
#pragma unroll
            for (int ai = 0; ai < 2; ++ai)
#pragma unroll
                for (int m = 0; m < 4; ++m)
#pragma unroll
                    for (int bj = 0; bj < 2; ++bj) { float g0[8]; unpack8(gw[ai][m][bj], g0);
#pragma unroll
                        for (int n = 0; n < 2; ++n)
#pragma unroll
                            for (int j = 0; j < 4; ++j) acc[ai][bj][m][n][j] *= g0[n * 4 + j]; }
        }
#pragma unroll
        for (int ai = 0; ai < 2; ++ai)
#pragma unroll
            for (int m = 0; m < 4; ++m)
#pragma unroll
                for (int bj = 0; bj < 2; ++bj) gw[ai][m][bj] = *(const u32x4*)(Pb + (unsigned)(((u.pm * 256 + ai * 128 + wr * 64 + m * 16 + fr) * INW + col0 + bj * 128 + 2304) * 2));
#pragma unroll
        for (int ai = 0; ai < 2; ++ai)
#pragma unroll
            for (int m = 0; m < 4; ++m)
#pragma unroll
                for (int bj = 0; bj < 2; ++bj) {
                    const int row = u.pm * 256 + ai * 128 + wr * 64 + m * 16 + fr, col = col0 + bj * 128;
                    float g1[8]; unpack8(gw[ai][m][bj], g1);
                    if (u.z == 0) {
#pragma unroll
                        for (int n = 0; n < 2; ++n)
#pragma unroll
                            for (int j = 0; j < 4; ++j) acc[ai][bj][m][n][j] *= __builtin_amdgcn_rcpf(__builtin_fmaxf(g1[n * 4 + j], 1.0e-30f));
                    } else {
                        float v[8];
#pragma unroll
                        for (int n = 0; n < 2; ++n)
#pragma unroll
                            for (int j = 0; j < 4; ++j) v[n * 4 + j] = acc[ai][bj][m][n][j] * g1[n * 4 + j];
                        *(u32x4*)((char*)MIX + (unsigned)((row * DM + col) * 2)) = pack8(v);
                    }
                }
    }
};
template <bool RES_F32, bool OUT_F32> struct EpiRes {
    static constexpr bool PERM = true;
    const float* res; float* out; bf16_t* XB; float* ssq_next;
    __device__ __forceinline__ void finish(const f32x4 x0, const f32x4 x1, int row, int col, float& s) const {
        if (OUT_F32) { *(f32x4*)(out + (size_t)row * DM + col) = x0; *(f32x4*)(out + (size_t)row * DM + col + 4) = x1; }
        else { u32x4 w; w.x = cvt_pk_bf16(x0[0], x0[1]); w.y = cvt_pk_bf16(x0[2], x0[3]); w.z = cvt_pk_bf16(x1[0], x1[1]); w.w = cvt_pk_bf16(x1[2], x1[3]); *(u32x4*)(XB + (size_t)row * DM + col) = w; }
        s += (x0[0] * x0[0] + x0[1] * x0[1]) + (x0[2] * x0[2] + x0[3] * x0[3]) + (x1[0] * x1[0] + x1[1] * x1[1]) + (x1[2] * x1[2] + x1[3] * x1[3]);
    }
    __device__ __forceinline__ void operator()(AccT& acc, const Unit& u, int wr, int wc, int fr, int fq) const {
        const int col0 = u.pn * 256 + wc * 32 + 8 * fq;
        if constexpr (!RES_F32) {
            u32x4 rb[2][4][2];
#pragma unroll
            for (int ai = 0; ai < 2; ++ai)
#pragma unroll
                for (int m = 0; m < 4; ++m)
#pragma unroll
                    for (int bj = 0; bj < 2; ++bj) rb[ai][m][bj] = *(const u32x4*)((const char*)XB + (unsigned)(((u.pm * 256 + ai * 128 + wr * 64 + m * 16 + fr) * DM + col0 + bj * 128) * 2));
#pragma unroll
            for (int ai = 0; ai < 2; ++ai)
#pragma unroll
                for (int m = 0; m < 4; ++m) {
                    const int row = u.pm * 256 + ai * 128 + wr * 64 + m * 16 + fr; float s = 0.f;
#pragma unroll
                    for (int bj = 0; bj < 2; ++bj) { const u32x4 w = rb[ai][m][bj];
                        finish((f32x4){bf_lo(w.x), bf_hi(w.x), bf_lo(w.y), bf_hi(w.y)} + acc[ai][bj][m][0], (f32x4){bf_lo(w.z), bf_hi(w.z), bf_lo(w.w), bf_hi(w.w)} + acc[ai][bj][m][1], row, col0 + bj * 128, s); }
                    if (!OUT_F32) { s += __shfl_xor(s, 16); s += __shfl_xor(s, 32); if (fq == 0) atomicAdd(ssq_next + row, s); }
                }
        } else {
#pragma unroll
            for (int ai = 0; ai < 2; ++ai) {
                f32x4 rv[4][2][2];
#pragma unroll
                for (int m = 0; m < 4; ++m)
#pragma unroll
                    for (int bj = 0; bj < 2; ++bj) { const size_t o = (size_t)(u.pm * 256 + ai * 128 + wr * 64 + m * 16 + fr) * DM + col0 + bj * 128; rv[m][bj][0] = *(const f32x4*)(res + o); rv[m][bj][1] = *(const f32x4*)(res + o + 4); }
#pragma unroll
                for (int m = 0; m < 4; ++m) {
                    const int row = u.pm * 256 + ai * 128 + wr * 64 + m * 16 + fr; float s = 0.f;
#pragma unroll
                    for (int bj = 0; bj < 2; ++bj) finish(rv[m][bj][0] + acc[ai][bj][m][0], rv[m][bj][1] + acc[ai][bj][m][1], row, col0 + bj * 128, s);
                    if (!OUT_F32) { s += __shfl_xor(s, 16); s += __shfl_xor(s, 32); if (fq == 0) atomicAdd(ssq_next + row, s); }
                }
            }
        }
    }
};
struct EpiNone { static constexpr bool PERM = true; __device__ __forceinline__ void operator()(AccT& acc, const Unit& u, int wr, int wc, int fr, int fq) const { float s = 0.f;
#pragma unroll
        for (int ai = 0; ai < 2; ++ai)
#pragma unroll
            for (int bj = 0; bj < 2; ++bj)
#pragma unroll
                for (int m = 0; m < 4; ++m)
#pragma unroll
                    for (int n = 0; n < 2; ++n) s += acc[ai][bj][m][n][0] + acc[ai][bj][m][n][1] + acc[ai][bj][m][n][2] + acc[ai][bj][m][n][3];
        if (s == 123.456f) *sink = s; }
    float* sink; };
struct EpiUpConv {
    static constexpr bool PERM = true;
    bf16_t* U; const float* ssq; const float* cw; const float* cb; float* conv_p; LAS float* xch; float* halo;
    __device__ __forceinline__ void operator()(AccT& acc, const Unit& u, int wr, int wc, int fr, int fq) const {
        const int b = u.pm >> 6, tstart = (u.pm & 63) * 256;
        const long arow0 = (long)u.pm * 256;
        const int colg0 = u.pn * 128 + wc * 32 + fq * 8;
        f32x4 cwg[2][3], cwv[2][3], cbg[2], cbv[2];
#pragma unroll
        for (int n = 0; n < 1; ++n) { const int colg = colg0 + n * 4, colv = FF + colg;
#pragma unroll
            for (int j = 0; j < 3; ++j) { cwg[n][j] = *(const f32x4*)(cw + j * FF2 + colg); cwv[n][j] = *(const f32x4*)(cw + j * FF2 + colv); }
            cbg[n] = *(const f32x4*)(cb + colg); cbv[n] = *(const f32x4*)(cb + colv); }
        float sq[2][4];
#pragma unroll
        for (int ai = 0; ai < 2; ++ai)
#pragma unroll
            for (int m = 0; m < 4; ++m) { const int rl = ai * 128 + wr * 64 + m * 16 + fr, t = tstart + rl; sq[ai][m] = ssq[arow0 + rl]; }
#pragma unroll
        for (int ai = 0; ai < 2; ++ai)
#pragma unroll
            for (int m = 0; m < 4; ++m) {
                const int rl = ai * 128 + wr * 64 + m * 16 + fr;
                const int t = tstart + rl;
                const float rs = __builtin_amdgcn_rsqf(sq[ai][m] * (1.0f / 1024.0f) + EPS);
#pragma unroll
                for (int bj = 0; bj < 2; ++bj)
#pragma unroll
                    for (int n = 0; n < 2; ++n) acc[ai][bj][m][n] = acc[ai][bj][m][n] * rs;
            }
        if (fr >= 14) {
#pragma unroll
            for (int ai = 0; ai < 2; ++ai)
#pragma unroll
                for (int bj = 0; bj < 2; ++bj)
#pragma unroll
                    for (int n = 0; n < 2; ++n)
                        *(LAS f32x4*)(xch + (((ai * 2 + wr) * 2 + (fr - 14)) * 256 + bj * 128 + wc * 32 + fq * 8 + n * 4)) = acc[ai][bj][3][n];
        }
        asm volatile("s_waitcnt lgkmcnt(0)" ::: "memory"); __builtin_amdgcn_s_barrier(); asm volatile("" ::: "memory");
        u32x2 stash[2][4];
#pragma unroll
        for (int n = 0; n < 2; ++n) {
            const int colg = colg0 + n * 4, colv = FF + colg;
            if (n == 1) {
#pragma unroll
                for (int j = 0; j < 3; ++j) { cwg[1][j] = *(const f32x4*)(cw + j * FF2 + colg); cwv[1][j] = *(const f32x4*)(cw + j * FF2 + colv); }
                cbg[1] = *(const f32x4*)(cb + colg); cbv[1] = *(const f32x4*)(cb + colv); }
            const f32x4 w0g = cwg[n][0], w1g = cwg[n][1], w2g = cwg[n][2], bg = cbg[n];
            const f32x4 w0v = cwv[n][0], w1v = cwv[n][1], w2v = cwv[n][2], bv = cbv[n];
#pragma unroll
            for (int ai = 0; ai < 2; ++ai) {
                f32x4 hg = (f32x4){0.f, 0.f, 0.f, 0.f}, hv = hg;
                const int s = ai * 2 + wr;
                if (s > 0 && fr >= 14) {
                    hg = *(const LAS f32x4*)(xch + (((s - 1) * 2 + (fr - 14)) * 256 + wc * 32 + fq * 8 + n * 4));
                    hv = *(const LAS f32x4*)(xch + (((s - 1) * 2 + (fr - 14)) * 256 + 128 + wc * 32 + fq * 8 + n * 4));
                }
#pragma unroll
                for (int m = 0; m < 4; ++m) {
                    const int rl = ai * 128 + wr * 64 + m * 16 + fr;
                    const f32x4 cg_ = acc[ai][0][m][n], cv_ = acc[ai][1][m][n];
                    f32x4 p1g, p2g, p1v, p2v;
#pragma unroll
                    for (int j = 0; j < 4; ++j) {
                        p1g[j] = ror1(fr == 15 ? hg[j] : cg_[j]); p2g[j] = ror2(fr >= 14 ? hg[j] : cg_[j]);
                        p1v[j] = ror1(fr == 15 ? hv[j] : cv_[j]); p2v[j] = ror2(fr >= 14 ? hv[j] : cv_[j]);
                    }
                    const f32x4 hcg = bg + w0g * p2g + w1g * p1g + w2g * cg_;
                    const f32x4 hcv = bv + w0v * p2v + w1v * p1v + w2v * cv_;
                    const f32x2 ga = gelu_pk((f32x2){hcg[0], hcg[1]}), gb2 = gelu_pk((f32x2){hcg[2], hcg[3]});
                    u32x2 w; w.x = cvt_pk_bf16(ga.x * hcv[0], ga.y * hcv[1]); w.y = cvt_pk_bf16(gb2.x * hcv[2], gb2.y * hcv[3]);
                    const int t = tstart + rl;
                    if (n == 0) stash[ai][m] = w;
                    else if (rl >= 2) *(u32x4*)(U + (size_t)(arow0 + rl) * FF + colg0) = (u32x4){stash[ai][m].x, stash[ai][m].y, w.x, w.y};
                    if (rl < 2 || rl >= 254) { float* hp = halo + ((size_t)u.pm * 4 + (rl < 2 ? rl : rl - 252)) * FF2; *(f32x4*)(hp + colg) = cg_; *(f32x4*)(hp + colv) = cv_; }
                    if (t >= SEQ - 2) { float* cp = conv_p + (size_t)(b * 2 + (t - (SEQ - 2))) * FF2; *(f32x4*)(cp + colg) = cg_; *(f32x4*)(cp + colv) = cv_; }
                    hg = cg_; hv = cv_;
                    if (m == 3) __builtin_amdgcn_sched_barrier(0);
                }
            }
        }
    }
};


__device__ __forceinline__ void conv_fixup(const Params& p, int l, int pm) {
    int tid = threadIdx.x; asm volatile("" : "+v"(tid));
    const float* halo = (const float*)(p.ws + WS_HALO); bf16_t* U = (bf16_t*)(p.ws + WS_PROJ);
    const float* cw = p.conv_w + (size_t)l * 3 * FF2; const float* cb = p.conv_b + (size_t)l * FF2;
    const bool first = (pm & 63) == 0;
#pragma unroll 1
    for (int q = tid; q < FF / 4; q += 512) {
        const int cg = 4 * q, cv = FF + cg;
        const f32x4 z = (f32x4){0.f, 0.f, 0.f, 0.f};
        const float* hp = halo + (size_t)(pm - 1) * 4 * FF2; const float* hc_ = halo + (size_t)pm * 4 * FF2;
        const f32x4 a2g = first ? z : *(const f32x4*)(hp + 2 * FF2 + cg), a2v = first ? z : *(const f32x4*)(hp + 2 * FF2 + cv);
        const f32x4 a1g = first ? z : *(const f32x4*)(hp + 3 * FF2 + cg), a1v = first ? z : *(const f32x4*)(hp + 3 * FF2 + cv);
        const f32x4 r0g = *(const f32x4*)(hc_ + cg), r0v = *(const f32x4*)(hc_ + cv), r1g = *(const f32x4*)(hc_ + FF2 + cg), r1v = *(const f32x4*)(hc_ + FF2 + cv);
        const f32x4 w0g = *(const f32x4*)(cw + cg), w1g = *(const f32x4*)(cw + FF2 + cg), w2g = *(const f32x4*)(cw + 2 * FF2 + cg), bg = *(const f32x4*)(cb + cg);
        const f32x4 w0v = *(const f32x4*)(cw + cv), w1v = *(const f32x4*)(cw + FF2 + cv), w2v = *(const f32x4*)(cw + 2 * FF2 + cv), bv = *(const f32x4*)(cb + cv);
#pragma unroll
        for (int r = 0; r < 2; ++r) {
            const f32x4 hcg = bg + w0g * (r == 0 ? a2g : a1g) + w1g * (r == 0 ? a1g : r0g) + w2g * (r == 0 ? r0g : r1g);
            const f32x4 hcv = bv + w0v * (r == 0 ? a2v : a1v) + w1v * (r == 0 ? a1v : r0v) + w2v * (r == 0 ? r0v : r1v);
            const f32x2 ga = gelu_pk((f32x2){hcg[0], hcg[1]}), gb2 = gelu_pk((f32x2){hcg[2], hcg[3]});
            u32x2 w; w.x = cvt_pk_bf16(ga.x * hcv[0], ga.y * hcv[1]); w.y = cvt_pk_bf16(gb2.x * hcv[2], gb2.y * hcv[3]);
            *(u32x2*)(U + (size_t)(pm * 256 + r) * FF + cg) = w;
        }
    }
}

template <int NB, int UN>
__device__ __forceinline__ void small_mma(f32x4 (&acc)[NB], const bf16_t* ap, const bf16_t* const (&bp)[NB], int K) {
#pragma unroll 1
    for (int k0 = 0; k0 < K; k0 += 32 * UN) {
        bf16x8 a[UN], b[NB][UN];
#pragma unroll
        for (int u = 0; u < UN; ++u) { a[u] = *(const bf16x8*)(ap + k0 + 32 * u);
#pragma unroll
            for (int nb = 0; nb < NB; ++nb) b[nb][u] = *(const bf16x8*)(bp[nb] + k0 + 32 * u); }
#pragma unroll
        for (int u = 0; u < UN; ++u)
#pragma unroll
            for (int nb = 0; nb < NB; ++nb) acc[nb] = __builtin_amdgcn_mfma_f32_16x16x32_bf16(b[nb][u], a[u], acc[nb], 0, 0, 0);
    }
}
struct SmallId { int w, fr, fq, row; };
__device__ __forceinline__ SmallId small_id() { int tid = threadIdx.x; asm volatile("" : "+v"(tid)); SmallId i; i.w = __builtin_amdgcn_readfirstlane(tid >> 6); i.fr = tid & 15; i.fq = (tid & 63) >> 4; i.row = MP + 16 * i.w + i.fr; return i; }


template <int KSTEPS  >
__device__ __forceinline__ void small_mma_ksplit(f32x4 (&acc)[2], const bf16_t* A, int lda, const bf16_t* Bt, int ldb, int n0, LAS unsigned char* lds, const SmallId& id) {
    const int lane = id.fq * 16 + id.fr, k0 = id.w * (KSTEPS * 32);
    f32x4 part[8][2];
#pragma unroll
    for (int rb = 0; rb < 8; ++rb) { part[rb][0] = (f32x4){0.f, 0.f, 0.f, 0.f}; part[rb][1] = part[rb][0]; }
    const bf16_t* ap = A + (size_t)(MP + id.fr) * lda + k0 + 8 * id.fq;
    const bf16_t* bp = Bt + (size_t)(n0 + id.fr) * ldb + k0 + 8 * id.fq;
#pragma unroll 1
    for (int ks = 0; ks < KSTEPS; ++ks) {
        bf16x8 a[8], b[2];
#pragma unroll
        for (int rb = 0; rb < 8; ++rb) a[rb] = *(const bf16x8*)(ap + (size_t)(16 * rb) * lda + 32 * ks);
        b[0] = *(const bf16x8*)(bp + 32 * ks); b[1] = *(const bf16x8*)(bp + (size_t)16 * ldb + 32 * ks);
#pragma unroll
        for (int rb = 0; rb < 8; ++rb) { part[rb][0] = __builtin_amdgcn_mfma_f32_16x16x32_bf16(b[0], a[rb], part[rb][0], 0, 0, 0); part[rb][1] = __builtin_amdgcn_mfma_f32_16x16x32_bf16(b[1], a[rb], part[rb][1], 0, 0, 0); }
    }
    LAS f32x4* red = (LAS f32x4*)lds;
#pragma unroll
    for (int rb = 0; rb < 8; ++rb) { red[((id.w * 8 + rb) * 2 + 0) * 64 + lane] = part[rb][0]; red[((id.w * 8 + rb) * 2 + 1) * 64 + lane] = part[rb][1]; }
    asm volatile("s_waitcnt lgkmcnt(0)" ::: "memory"); __syncthreads();
    acc[0] = (f32x4){0.f, 0.f, 0.f, 0.f}; acc[1] = acc[0];
#pragma unroll
    for (int w2 = 0; w2 < 8; ++w2) { acc[0] += red[((w2 * 8 + id.w) * 2 + 0) * 64 + lane]; acc[1] += red[((w2 * 8 + id.w) * 2 + 1) * 64 + lane]; }
    asm volatile("s_waitcnt lgkmcnt(0)" ::: "memory"); __syncthreads();
}

__device__ __forceinline__ void small_proj(const Params& p, int l, int G, int bx) {
    const SmallId id = small_id();
    const bf16_t* XB = (const bf16_t*)(p.ws + WS_XB); const bf16_t* Bt = (const bf16_t*)(p.ws + WS_W + (size_t)l * W_LAYER + WO_IN); bf16_t* PROJ = (bf16_t*)(p.ws + WS_PROJ);
    const float* ssq = (const float*)(p.ws + WS_SSQ) + (2 * l) * MPAD; const float* gb = p.gate_bias + l * 2048;
    for (int ts = G - 1 - bx; ts < INW / 32; ts += G) {
        const int n0 = ts * 32; f32x4 acc[2] = {(f32x4){0.f, 0.f, 0.f, 0.f}, (f32x4){0.f, 0.f, 0.f, 0.f}};
        const bf16_t* ap = XB + (size_t)id.row * DM + 8 * id.fq;
        const bf16_t* const bp[2] = {Bt + (size_t)(n0 + id.fr) * DM + 8 * id.fq, Bt + (size_t)(n0 + 16 + id.fr) * DM + 8 * id.fq};
        small_mma<2, 8>(acc, ap, bp, DM);
        const float rs = __builtin_amdgcn_rsqf(ssq[id.row] * (1.0f / 1024.0f) + EPS);
#pragma unroll
        for (int nb = 0; nb < 2; ++nb) { const int col = n0 + 16 * nb + 4 * id.fq; float v[4];
#pragma unroll
            for (int j = 0; j < 4; ++j) { float x = acc[nb][j] * rs; if (n0 >= 1280) { x += gb[col - 1280 + j]; x = __builtin_amdgcn_rcpf(1.0f + __builtin_amdgcn_exp2f(-LOG2E * x)); } v[j] = x; }
            u32x2 w; w.x = cvt_pk_bf16(v[0], v[1]); w.y = cvt_pk_bf16(v[2], v[3]); *(u32x2*)(PROJ + (size_t)id.row * INW + col) = w; }
    }
}
__device__ __forceinline__ void small_mix(const Params& p, int l, LAS unsigned char* lds, int G, int bx) {
    const SmallId id = small_id();
    const bf16_t* AD = (const bf16_t*)(p.ws + WS_AD); const bf16_t* Bm = (const bf16_t*)(p.ws + WS_W + (size_t)l * W_LAYER + WO_MIX); const bf16_t* PROJ = (const bf16_t*)(p.ws + WS_PROJ); bf16_t* MIX = (bf16_t*)(p.ws + WS_MIX);
    for (int ts = G - 1 - bx; ts < DM / 32; ts += G) {
        const int n0 = ts * 32; f32x4 ya[2] = {(f32x4){0.f, 0.f, 0.f, 0.f}, (f32x4){0.f, 0.f, 0.f, 0.f}}, yb[2] = {(f32x4){0.f, 0.f, 0.f, 0.f}, (f32x4){0.f, 0.f, 0.f, 0.f}};
        small_mma_ksplit<2>(ya, AD, DM, Bm, 512, n0, lds, id);
        small_mma_ksplit<2>(yb, AD + 512, DM, Bm + (size_t)1024 * 512, 512, n0, lds, id);
#pragma unroll
        for (int nb = 0; nb < 2; ++nb) { const int col = n0 + 16 * nb + 4 * id.fq;
            const u32x2 g0 = *(const u32x2*)(PROJ + (size_t)id.row * INW + 1280 + col), g1 = *(const u32x2*)(PROJ + (size_t)id.row * INW + 2304 + col);
            const float v0 = bf_lo(g0.x) * ya[nb][0] + bf_lo(g1.x) * yb[nb][0], v1 = bf_hi(g0.x) * ya[nb][1] + bf_hi(g1.x) * yb[nb][1];
            const float v2 = bf_lo(g0.y) * ya[nb][2] + bf_lo(g1.y) * yb[nb][2], v3 = bf_hi(g0.y) * ya[nb][3] + bf_hi(g1.y) * yb[nb][3];
            u32x2 w; w.x = cvt_pk_bf16(v0, v1); w.y = cvt_pk_bf16(v2, v3); *(u32x2*)(MIX + (size_t)id.row * DM + col) = w; }
    }
}
template <bool RES_F32, bool OUT_F32, int KSTEPS>
__device__ __forceinline__ void small_res(const Params& p, LAS unsigned char* lds, const bf16_t* A, int lda, const bf16_t* Bt, int K, float* ssq_next, int G, int bx) {
    const SmallId id = small_id();
    bf16_t* XB = (bf16_t*)(p.ws + WS_XB);
    for (int ts = G - 1 - bx; ts < DM / 32; ts += G) {
        const int n0 = ts * 32; f32x4 acc[2] = {(f32x4){0.f, 0.f, 0.f, 0.f}, (f32x4){0.f, 0.f, 0.f, 0.f}};
        small_mma_ksplit<KSTEPS>(acc, A, lda, Bt, K, n0, lds, id);
        float s = 0.f;
#pragma unroll
        for (int nb = 0; nb < 2; ++nb) { const int col = n0 + 16 * nb + 4 * id.fq;
            f32x4 r;
            if (RES_F32) r = *(const f32x4*)(p.xs + (size_t)(id.row - MP) * DM + col);
            else { const u32x2 w = *(const u32x2*)(XB + (size_t)id.row * DM + col); r = (f32x4){bf_lo(w.x), bf_hi(w.x), bf_lo(w.y), bf_hi(w.y)}; }
            const f32x4 x = r + acc[nb];
            if (OUT_F32) *(f32x4*)(p.out + (size_t)id.row * DM + col) = x;
            else { u32x2 w; w.x = cvt_pk_bf16(x[0], x[1]); w.y = cvt_pk_bf16(x[2], x[3]); *(u32x2*)(XB + (size_t)id.row * DM + col) = w; }
            s += (x[0] * x[0] + x[1] * x[1]) + (x[2] * x[2] + x[3] * x[3]); }
        if (!OUT_F32) { s += __shfl_xor(s, 16); s += __shfl_xor(s, 32); if (id.fq == 0) atomicAdd(ssq_next + id.row, s); }
    }
}
__device__ __forceinline__ void small_up(const Params& p, int l, int G, int bx) {
    const SmallId id = small_id();
    const bf16_t* XB = (const bf16_t*)(p.ws + WS_XB); const bf16_t* Bu = (const bf16_t*)(p.ws + WS_W + (size_t)l * W_LAYER + WO_UP); bf16_t* U = (bf16_t*)(p.ws + WS_PROJ);
    const float* ssq = (const float*)(p.ws + WS_SSQ) + (2 * l + 1) * MPAD;
    const float* cw = p.conv_w + (size_t)l * 3 * FF2; const float* cb = p.conv_b + (size_t)l * FF2; const float* sconv = p.state_conv + (size_t)l * 8 * 2 * FF2; float* conv_s = p.out + O_CS + (size_t)l * 8 * 2 * FF2;
    for (int ts = G - 1 - bx; ts < FF / 32; ts += G) {
        const int c0 = ts * 32; f32x4 acc[4];
#pragma unroll
        for (int i = 0; i < 4; ++i) acc[i] = (f32x4){0.f, 0.f, 0.f, 0.f};
        const bf16_t* ap = XB + (size_t)id.row * DM + 8 * id.fq;
        const int rb0 = (c0 >> 7) * 256 + (c0 & 127);
        const bf16_t* const bp[4] = {Bu + (size_t)(rb0 + id.fr) * DM + 8 * id.fq, Bu + (size_t)(rb0 + 16 + id.fr) * DM + 8 * id.fq,
                                     Bu + (size_t)(rb0 + 128 + id.fr) * DM + 8 * id.fq, Bu + (size_t)(rb0 + 128 + 16 + id.fr) * DM + 8 * id.fq};
        small_mma<4, 4>(acc, ap, bp, DM);
        const float rs = __builtin_amdgcn_rsqf(ssq[id.row] * (1.0f / 1024.0f) + EPS);
        const int fr = id.fr;
#pragma unroll
        for (int nb = 0; nb < 2; ++nb) {
            const int colg = c0 + 16 * nb + 4 * id.fq, colv = FF + colg;
            const f32x4 cg_ = acc[nb] * rs, cv_ = acc[2 + nb] * rs;
            f32x4 hg = (f32x4){0.f, 0.f, 0.f, 0.f}, hv = hg;
            if (fr >= 14) { const float* sp = sconv + (size_t)(id.w * 2 + (fr - 14)) * FF2; hg = *(const f32x4*)(sp + colg); hv = *(const f32x4*)(sp + colv); }
            const f32x4 w0g = *(const f32x4*)(cw + colg), w1g = *(const f32x4*)(cw + FF2 + colg), w2g = *(const f32x4*)(cw + 2 * FF2 + colg), bg = *(const f32x4*)(cb + colg);
            const f32x4 w0v = *(const f32x4*)(cw + colv), w1v = *(const f32x4*)(cw + FF2 + colv), w2v = *(const f32x4*)(cw + 2 * FF2 + colv), bv = *(const f32x4*)(cb + colv);
            f32x4 p1g, p2g, p1v, p2v;
#pragma unroll
            for (int j = 0; j < 4; ++j) {
                p1g[j] = ror1(fr == 15 ? hg[j] : cg_[j]); p2g[j] = ror2(fr >= 14 ? hg[j] : cg_[j]);
                p1v[j] = ror1(fr == 15 ? hv[j] : cv_[j]); p2v[j] = ror2(fr >= 14 ? hv[j] : cv_[j]);
            }
            const f32x4 hcg = bg + w0g * p2g + w1g * p1g + w2g * cg_;
            const f32x4 hcv = bv + w0v * p2v + w1v * p1v + w2v * cv_;
            const f32x2 ga = gelu_pk((f32x2){hcg[0], hcg[1]}), gb2 = gelu_pk((f32x2){hcg[2], hcg[3]});
            u32x2 w; w.x = cvt_pk_bf16(ga.x * hcv[0], ga.y * hcv[1]); w.y = cvt_pk_bf16(gb2.x * hcv[2], gb2.y * hcv[3]);
            *(u32x2*)(U + (size_t)id.row * FF + colg) = w;
            if (fr >= 14) { float* cp = conv_s + (size_t)(id.w * 2 + (fr - 14)) * FF2; *(f32x4*)(cp + colg) = cg_; *(f32x4*)(cp + colv) = cv_; }
        }
    }
}

__device__ __forceinline__ int crow(int r, int hi) { return (r & 3) + 8 * (r >> 2) + 4 * hi; }
constexpr int KS_LD = 72, VT_LD = 200, LDS_VT = 192 * KS_LD * 2, LDS_WSC = LDS_VT + 64 * VT_LD * 2, LDS_OST = LDS_WSC + 1024;


template <int W>
__device__ __forceinline__ void pool_items(const Params& p, int l, bool sample, int b, int c, int g, long row0, int tid) {
    const bf16_t* P = (const bf16_t*)(p.ws + WS_PROJ);
    bf16_t* AD = (bf16_t*)(p.ws + WS_AD);
    const int nitems = sample ? 16 * 16 : 64 * 16;
#pragma unroll 1
    for (int it = tid; it < nitems; it += 512) {
        const int tl = it >> 4, ch = it & 15, col = g * 128 + ch * 8;
        const long prow = row0 + tl; const int t = sample ? tl : c * 64 + tl;
        u32x4 raw[W]; f32x4 h0[W], h1[W];
#pragma unroll
        for (int i = 0; i < W; ++i) {
            const int tt = t - i;
            raw[i] = (u32x4){0u, 0u, 0u, 0u}; h0[i] = (f32x4){0.f, 0.f, 0.f, 0.f}; h1[i] = h0[i];
            if (tt >= 0) raw[i] = *(const u32x4*)(P + (size_t)(prow - i) * INW + 768 + col);
            else if (sample) { const float* sp = p.state_pool + (((size_t)l * 8 + b) * 15 + (15 + tt)) * 512 + col; h0[i] = *(const f32x4*)sp; h1[i] = *(const f32x4*)(sp + 4); }
        }
        float cur[8], a[8];
        unpack8(raw[0], cur);
#pragma unroll
        for (int k = 0; k < 8; ++k) a[k] = cur[k];
#pragma unroll
        for (int i = 1; i < W; ++i) { float x[8]; unpack8(raw[i], x);
#pragma unroll
            for (int k = 0; k < 4; ++k) { a[k] += x[k] + h0[i][k]; a[4 + k] += x[4 + k] + h1[i][k]; } }
        const float cnt = sample ? (float)W : (float)((t + 1) < W ? (t + 1) : W);
        const float inv = 1.0f / cnt;
        float d[8];
#pragma unroll
        for (int k = 0; k < 8; ++k) d[k] = a[k] * inv - cur[k];
        *(u32x4*)(AD + (size_t)prow * DM + 512 + col) = pack8(d);
        float* pd = nullptr;
        if (!sample) { if (t >= SEQ - 15) pd = p.out + O_PP + (((size_t)l * 2 + b) * 15 + (t - (SEQ - 15))) * 512 + col; }
        else if (tl >= 1) pd = p.out + O_PS + (((size_t)l * 8 + b) * 15 + (tl - 1)) * 512 + col;
        if (pd) { *(f32x4*)pd = (f32x4){cur[0], cur[1], cur[2], cur[3]}; *(f32x4*)(pd + 4) = (f32x4){cur[4], cur[5], cur[6], cur[7]}; }
    }
}

template <int W>
__device__ __forceinline__ void pool_task_prompt(const Params& p, int l, int b, int c, int g, int rg, int ch, long row0) {
    const bf16_t* P = (const bf16_t*)(p.ws + WS_PROJ);
    bf16_t* AD = (bf16_t*)(p.ws + WS_AD);
    const int col = g * 128 + ch * 8, tl0 = 4 * rg, t0 = c * 64 + tl0;
    u32x4 raw[W + 3];
#pragma unroll
    for (int i = 0; i < W + 3; ++i) { const int tt = t0 - (W - 1) + i; raw[i] = (u32x4){0u, 0u, 0u, 0u};
        if (tt >= 0) raw[i] = *(const u32x4*)(P + (size_t)((long)b * SEQ + tt) * INW + 768 + col); }
    float a[4][8], cur[4][8];
#pragma unroll
    for (int k = 0; k < 8; ++k) a[0][k] = 0.f;
#pragma unroll
    for (int i = 0; i < W; ++i) { float x[8]; unpack8(raw[i], x);
#pragma unroll
        for (int k = 0; k < 8; ++k) { a[0][k] += x[k]; if (i == W - 1) cur[0][k] = x[k]; } }
#pragma unroll
    for (int r = 1; r < 4; ++r) { float xin[8], xout[8]; unpack8(raw[W - 1 + r], xin); unpack8(raw[r - 1], xout);
#pragma unroll
        for (int k = 0; k < 8; ++k) { a[r][k] = a[r - 1][k] + (xin[k] - xout[k]); cur[r][k] = xin[k]; } }
#pragma unroll
    for (int r = 0; r < 4; ++r) {
        const int t = t0 + r;
        const float inv = 1.0f / (float)((t + 1) < W ? (t + 1) : W);
        float d[8];
#pragma unroll
        for (int k = 0; k < 8; ++k) d[k] = a[r][k] * inv - cur[r][k];
        *(u32x4*)(AD + (size_t)(row0 + tl0 + r) * DM + 512 + col) = pack8(d);
        if (t >= SEQ - 15) { float* pd = p.out + O_PP + (((size_t)l * 2 + b) * 15 + (t - (SEQ - 15))) * 512 + col;
            *(f32x4*)pd = (f32x4){cur[r][0], cur[r][1], cur[r][2], cur[r][3]}; *(f32x4*)(pd + 4) = (f32x4){cur[r][4], cur[r][5], cur[r][6], cur[r][7]}; }
    }
}

__device__ __forceinline__ void attn_unit(const Params& p, int l, LAS unsigned char* lds, bool sample, int b, int c, int kvh) {
    int tid = threadIdx.x; asm volatile("" : "+v"(tid));
    const int wid = __builtin_amdgcn_readfirstlane(tid >> 6);
    int lane = tid & 63; asm volatile("" : "+v"(lane));
    const int q32 = lane & 31, hi = lane >> 5;
    LAS bf16_t* Ks = (LAS bf16_t*)lds; LAS bf16_t* Vt = (LAS bf16_t*)(lds + LDS_VT); LAS float* wsc = (LAS float*)(lds + LDS_WSC) + wid * 32;
    const bf16_t* P = (const bf16_t*)(p.ws + WS_PROJ);
    bf16_t* AD = (bf16_t*)(p.ws + WS_AD);
    const long row0 = sample ? (long)MP + b * 16 : (long)b * SEQ + c * 64;
    if (sample) {
#pragma unroll
        for (int gl = 0; gl < 2; ++gl) {
            const int g = kvh * 2 + gl;
            if (g == 0) pool_items<2>(p, l, sample, b, c, g, row0, tid);
            else if (g == 1) pool_items<4>(p, l, sample, b, c, g, row0, tid);
            else if (g == 2) pool_items<8>(p, l, sample, b, c, g, row0, tid);
            else pool_items<16>(p, l, sample, b, c, g, row0, tid);
        }
        __builtin_amdgcn_sched_barrier(0);
    }
    const int gq = wid >> 1, half = wid & 1, h = kvh * 4 + gq;
    const bool active = !sample || half == 0;
    const int tq = half * 32 + q32;
    const long qrow = sample ? row0 + (q32 & 15) : row0 + tq;
    u32x4 qraw[4];
#pragma unroll
    for (int d0 = 0; d0 < 4; ++d0) qraw[d0] = *(const u32x4*)(P + (size_t)qrow * INW + h * 64 + d0 * 16 + hi * 8);
    u32x4 kraw[3], vraw[3]; f32x4 kc0[3], kc1[3], vc0[3], vc1[3];
#pragma unroll
    for (int it = 0; it < 3; ++it) {
        const int idx = it * 512 + tid, j = idx >> 3, ch = idx & 7;
        kraw[it] = (u32x4){0u, 0u, 0u, 0u}; vraw[it] = kraw[it];
        kc0[it] = (f32x4){0.f, 0.f, 0.f, 0.f}; kc1[it] = kc0[it]; vc0[it] = kc0[it]; vc1[it] = kc0[it];
        if (!sample) { const int tk = c * 64 - 128 + j;
            if (tk >= 0) { const size_t o = (size_t)((long)b * SEQ + tk) * INW + kvh * 64 + ch * 8; kraw[it] = *(const u32x4*)(P + o + 512); vraw[it] = *(const u32x4*)(P + o + 640); } }
        else if (j < 128) { const size_t ci = ((((size_t)l * 8 + b) * 128 + j) * 2 + kvh) * 64 + ch * 8;
            kc0[it] = *(const f32x4*)(p.cache_k + ci); kc1[it] = *(const f32x4*)(p.cache_k + ci + 4); vc0[it] = *(const f32x4*)(p.cache_v + ci); vc1[it] = *(const f32x4*)(p.cache_v + ci + 4); }
        else if (j < 144) { const size_t o = (size_t)((long)MP + b * 16 + (j - 128)) * INW + kvh * 64 + ch * 8; kraw[it] = *(const u32x4*)(P + o + 512); vraw[it] = *(const u32x4*)(P + o + 640); }
    }
    if (!sample) {
        const int gl = tid >> 8, g = kvh * 2 + gl, rg = (tid >> 4) & 15, ch = tid & 15;
        if (g == 0) pool_task_prompt<2>(p, l, b, c, g, rg, ch, row0);
        else if (g == 1) pool_task_prompt<4>(p, l, b, c, g, rg, ch, row0);
        else if (g == 2) pool_task_prompt<8>(p, l, b, c, g, rg, ch, row0);
        else pool_task_prompt<16>(p, l, b, c, g, rg, ch, row0);
    }
    const float* knorm = p.k_norm + l * 64;
#pragma unroll
    for (int it = 0; it < 3; ++it) {
        const int idx = it * 512 + tid, j = idx >> 3, ch = idx & 7;
        float kf[8], vf[8];
        const bool fromproj = !sample || j >= 128;
        if (fromproj) { unpack8(kraw[it], kf); unpack8(vraw[it], vf); }
        else {
#pragma unroll
            for (int i = 0; i < 4; ++i) { kf[i] = kc0[it][i]; kf[4 + i] = kc1[it][i]; vf[i] = vc0[it][i]; vf[4 + i] = vc1[it][i]; } }
        float ss = 0.f;
#pragma unroll
        for (int i = 0; i < 8; ++i) ss += kf[i] * kf[i];
        ss += __shfl_xor(ss, 1); ss += __shfl_xor(ss, 2); ss += __shfl_xor(ss, 4);
        if (fromproj) { const float sc = __builtin_amdgcn_rsqf(ss * (1.0f / 64.0f) + EPS);
#pragma unroll
            for (int i = 0; i < 8; ++i) kf[i] = kf[i] * sc * knorm[ch * 8 + i]; }
        *(LAS u32x4*)(Ks + j * KS_LD + ch * 8) = pack8(kf);
#pragma unroll
        for (int i = 0; i < 8; i += 2) { const unsigned w = cvt_pk_bf16(vf[i], vf[i + 1]); const int js = j ^ (ch << 3);
            Vt[(ch * 8 + i) * VT_LD + js] = (bf16_t)(w & 0xffffu); Vt[(ch * 8 + i + 1) * VT_LD + js] = (bf16_t)(w >> 16); }
        float* kd = nullptr; float* vd = nullptr;
        if (!sample) { if (c >= 254 && j >= 128) { const size_t o = ((((size_t)l * 2 + b) * 128 + (c - 254) * 64 + (j - 128)) * 2 + kvh) * 64 + ch * 8; kd = p.out + O_KP + o; vd = p.out + O_VP + o; } }
        else if (j >= 16 && j < 144) { const size_t o = ((((size_t)l * 8 + b) * 128 + (j - 16)) * 2 + kvh) * 64 + ch * 8; kd = p.out + O_KS + o; vd = p.out + O_VS + o; }
        if (kd) { *(f32x4*)kd = (f32x4){kf[0], kf[1], kf[2], kf[3]}; *(f32x4*)(kd + 4) = (f32x4){kf[4], kf[5], kf[6], kf[7]};
                  *(f32x4*)vd = (f32x4){vf[0], vf[1], vf[2], vf[3]}; *(f32x4*)(vd + 4) = (f32x4){vf[4], vf[5], vf[6], vf[7]}; }
    }
    bf16x8 qf[4];
    {
        float qv[4][8]; float ss = 0.f;
#pragma unroll
        for (int d0 = 0; d0 < 4; ++d0) { unpack8(qraw[d0], qv[d0]);
#pragma unroll
            for (int i = 0; i < 8; ++i) ss += qv[d0][i] * qv[d0][i]; }
        ss += __shfl_xor(ss, 32);
        const float sc = __builtin_amdgcn_rsqf(ss * (1.0f / 64.0f) + EPS) * (0.125f * LOG2E);
        const float* qn = p.q_norm + l * 64;
#pragma unroll
        for (int d0 = 0; d0 < 4; ++d0) { float t8[8];
#pragma unroll
            for (int i = 0; i < 8; ++i) t8[i] = qv[d0][i] * sc * qn[d0 * 16 + hi * 8 + i];
            qf[d0] = __builtin_bit_cast(bf16x8, pack8(t8)); }
    }
    __syncthreads();
    if (active) {
        f32x16 s[6];
#pragma unroll
        for (int kt = 0; kt < 6; ++kt) {
            s[kt] = (f32x16){};
#pragma unroll
            for (int d0 = 0; d0 < 4; ++d0) {
                const bf16x8 kfr = *(const LAS bf16x8*)(Ks + (kt * 32 + q32) * KS_LD + d0 * 16 + hi * 8);
                s[kt] = __builtin_amdgcn_mfma_f32_32x32x16_bf16(kfr, qf[d0], s[kt], 0, 0, 0);
            }
        }
        const float slope2 = __builtin_amdgcn_exp2f(-(float)(h + 1)) * LOG2E;
        const int jmin = sample ? 0 : (c >= 2 ? 0 : 128 - 64 * c), jmax = sample ? 144 : 192;
        float mx = -3.0e38f;
        const float relb = (float)(128 + tq - 4 * hi);
        const bool need_mask = sample || c < 2;
#pragma unroll
        for (int kt = 0; kt < 6; ++kt)
#pragma unroll
            for (int r = 0; r < 16; ++r) {
                float v = __builtin_fmaf(-slope2, __builtin_fabsf(relb - (float)(32 * kt + (r & 3) + 8 * (r >> 2))), s[kt][r]);
                if (need_mask) { const int j = 32 * kt + crow(r, hi); if (j < jmin || j >= jmax) v = -1.0e30f; }
                s[kt][r] = v; mx = __builtin_fmaxf(mx, v);
            }
        mx = __builtin_fmaxf(mx, __shfl_xor(mx, 32));
        const float sink2 = p.sinks[l * 8 + h] * LOG2E;
        const float mm = __builtin_fmaxf(mx, sink2);
        float sum = 0.f;
#pragma unroll
        for (int kt = 0; kt < 6; ++kt)
#pragma unroll
            for (int r = 0; r < 16; ++r) { const float e = __builtin_amdgcn_exp2f(s[kt][r] - mm); s[kt][r] = e; sum += e; }
        sum += __shfl_xor(sum, 32);
        const float denom = sum + __builtin_amdgcn_exp2f(sink2 - mm);
        if (hi == 0) wsc[q32] = 1.0f / denom;
        f32x16 o[2]; o[0] = (f32x16){}; o[1] = (f32x16){};
#pragma unroll
        for (int kt = 0; kt < 6; ++kt)
#pragma unroll
            for (int jj = 0; jj < 2; ++jj) {
                u32x4 pw;
                pw.x = cvt_pk_bf16(s[kt][8 * jj + 0], s[kt][8 * jj + 1]); pw.y = cvt_pk_bf16(s[kt][8 * jj + 2], s[kt][8 * jj + 3]);
                pw.z = cvt_pk_bf16(s[kt][8 * jj + 4], s[kt][8 * jj + 5]); pw.w = cvt_pk_bf16(s[kt][8 * jj + 6], s[kt][8 * jj + 7]);
                const bf16x8 pa = __builtin_bit_cast(bf16x8, pw);
                const int e0 = 32 * kt + 16 * jj + 4 * hi;
#pragma unroll
                for (int db = 0; db < 2; ++db) {
                    const int sw = (((db * 32 + q32) >> 3) & 7) << 3;
                    const u32x2 lo = *(const LAS u32x2*)(Vt + (db * 32 + q32) * VT_LD + (e0 ^ sw)), hi2 = *(const LAS u32x2*)(Vt + (db * 32 + q32) * VT_LD + ((e0 + 8) ^ sw));
                    const bf16x8 vb = __builtin_bit_cast(bf16x8, (u32x4){lo.x, lo.y, hi2.x, hi2.y});
                    o[db] = __builtin_amdgcn_mfma_f32_32x32x16_bf16(pa, vb, o[db], 0, 0, 0);
                }
                __builtin_amdgcn_sched_barrier(0);
            }
        asm volatile("s_waitcnt lgkmcnt(0)" ::: "memory");
        LAS bf16_t* ost = (LAS bf16_t*)(lds + LDS_OST) + wid * (32 * 72);
#pragma unroll
        for (int r = 0; r < 16; ++r) {
            const int qq = crow(r, hi);
            const float inv = wsc[qq];
#pragma unroll
            for (int db = 0; db < 2; ++db) ost[qq * 72 + db * 32 + q32] = (bf16_t)(cvt_pk_bf16(o[db][r] * inv, 0.f) & 0xffffu);
        }
        asm volatile("s_waitcnt lgkmcnt(0)" ::: "memory");
#pragma unroll
        for (int i = 0; i < 4; ++i) {
            const int row = i * 8 + (lane >> 3), chn = lane & 7;
            const u32x4 v = *(const LAS u32x4*)(ost + row * 72 + chn * 8);
            if (!sample || row < 16) { const long orow = sample ? row0 + row : row0 + half * 32 + row; *(u32x4*)(AD + (size_t)orow * DM + h * 64 + chn * 8) = v; }
        }
    }
    __syncthreads();
}


constexpr int MK_LD = 72, MV_LD = 392, M_VT = 384 * MK_LD * 2, M_WSC = M_VT + 64 * MV_LD * 2, M_OST = M_WSC + 1024;
static_assert(M_OST + 8 * 32 * 72 * 2 <= MISC_OFF, "attention macro-unit LDS map");
__device__ __forceinline__ void attn_macro(const Params& p, int l, LAS unsigned char* lds, int b, int cg, int kvh) {
    int tid = threadIdx.x; asm volatile("" : "+v"(tid));
    const int wid = __builtin_amdgcn_readfirstlane(tid >> 6);
    int lane = tid & 63; asm volatile("" : "+v"(lane));
    const int q32 = lane & 31, hi = lane >> 5;
    LAS bf16_t* Ks = (LAS bf16_t*)lds; LAS bf16_t* Vt = (LAS bf16_t*)(lds + M_VT); LAS float* wsc = (LAS float*)(lds + M_WSC) + wid * 32;
    const bf16_t* P = (const bf16_t*)(p.ws + WS_PROJ);
    bf16_t* AD = (bf16_t*)(p.ws + WS_AD);
    const int c0 = 4 * cg;
    const long rowb = (long)b * SEQ;
    const int gq = wid >> 1, half = wid & 1, h = kvh * 4 + gq, tq = half * 32 + q32;
    u32x4 qraw[4];
#pragma unroll
    for (int i = 0; i < 4; ++i) qraw[i] = *(const u32x4*)(P + (size_t)(rowb + c0 * 64 + half * 32 + i * 8 + (lane >> 3)) * INW + h * 64 + (lane & 7) * 8);
    u32x4 kraw[6], vraw[6];
#pragma unroll
    for (int it = 0; it < 6; ++it) {
        const int idx = it * 512 + tid, j = idx >> 3, ch = idx & 7, tk = c0 * 64 - 128 + j;
        kraw[it] = (u32x4){0u, 0u, 0u, 0u}; vraw[it] = kraw[it];
        if (tk >= 0) { const size_t o = (size_t)(rowb + tk) * INW + kvh * 64 + ch * 8; kraw[it] = *(const u32x4*)(P + o + 512); vraw[it] = *(const u32x4*)(P + o + 640); }
    }
    const float* knorm = p.k_norm + l * 64;
#pragma unroll
    for (int it = 0; it < 6; ++it) {
        const int idx = it * 512 + tid, j = idx >> 3, ch = idx & 7;
        float kf[8], vf[8]; unpack8(kraw[it], kf); unpack8(vraw[it], vf);
        float ss = 0.f;
#pragma unroll
        for (int i = 0; i < 8; ++i) ss += kf[i] * kf[i];
        ss += __shfl_xor(ss, 1); ss += __shfl_xor(ss, 2); ss += __shfl_xor(ss, 4);
        const float sc = __builtin_amdgcn_rsqf(ss * (1.0f / 64.0f) + EPS);
#pragma unroll
        for (int i = 0; i < 8; ++i) kf[i] = kf[i] * sc * knorm[ch * 8 + i];
        *(LAS u32x4*)(Ks + j * MK_LD + ch * 8) = pack8(kf);
        const int js = j ^ (ch << 3);
#pragma unroll
        for (int i = 0; i < 8; i += 2) { const unsigned w = cvt_pk_bf16(vf[i], vf[i + 1]); Vt[(ch * 8 + i) * MV_LD + js] = (bf16_t)(w & 0xffffu); Vt[(ch * 8 + i + 1) * MV_LD + js] = (bf16_t)(w >> 16); }
        if (cg == 63 && j >= 256) {
            const size_t o = ((((size_t)l * 2 + b) * 128 + (j - 256)) * 2 + kvh) * 64 + ch * 8; float* kd = p.out + O_KP + o; float* vd = p.out + O_VP + o;
            *(f32x4*)kd = (f32x4){kf[0], kf[1], kf[2], kf[3]}; *(f32x4*)(kd + 4) = (f32x4){kf[4], kf[5], kf[6], kf[7]};
            *(f32x4*)vd = (f32x4){vf[0], vf[1], vf[2], vf[3]}; *(f32x4*)(vd + 4) = (f32x4){vf[4], vf[5], vf[6], vf[7]};
        }
    }
    __syncthreads();
    const float slope2 = __builtin_amdgcn_exp2f(-(float)(h + 1)) * LOG2E;
    const float sink2 = p.sinks[l * 8 + h] * LOG2E;
    const float* qn = p.q_norm + l * 64;
#pragma unroll 1
    for (int ci = 0; ci < 4; ++ci) {
        const int c = c0 + ci;
        const long row0 = rowb + (long)c * 64;
        int lane_ = lane; asm volatile("" : "+v"(lane_));
        const int q32 = lane_ & 31, hi = lane_ >> 5, tq = half * 32 + q32;
        const float relb = (float)(128 + tq - 4 * hi);
        bf16x8 qf[4];
        {
            LAS bf16_t* qst = (LAS bf16_t*)(lds + M_OST) + wid * (32 * 72);
#pragma unroll
            for (int i = 0; i < 4; ++i) *(LAS u32x4*)(qst + (i * 8 + (lane_ >> 3)) * 72 + (lane_ & 7) * 8) = qraw[i];
            asm volatile("s_waitcnt lgkmcnt(0)" ::: "memory");
            float qv[4][8]; float ss = 0.f;
#pragma unroll
            for (int d0 = 0; d0 < 4; ++d0) { unpack8(*(const LAS u32x4*)(qst + q32 * 72 + d0 * 16 + hi * 8), qv[d0]);
#pragma unroll
                for (int i = 0; i < 8; ++i) ss += qv[d0][i] * qv[d0][i]; }
            asm volatile("s_waitcnt lgkmcnt(0)" ::: "memory");
            ss += __shfl_xor(ss, 32);
            const float sc = __builtin_amdgcn_rsqf(ss * (1.0f / 64.0f) + EPS) * (0.125f * LOG2E);
#pragma unroll
            for (int d0 = 0; d0 < 4; ++d0) { float t8[8];
#pragma unroll
                for (int i = 0; i < 8; ++i) t8[i] = qv[d0][i] * sc * qn[d0 * 16 + hi * 8 + i];
                qf[d0] = __builtin_bit_cast(bf16x8, pack8(t8)); }
        }
        if (ci < 3) {
#pragma unroll
            for (int i = 0; i < 4; ++i) qraw[i] = *(const u32x4*)(P + (size_t)(row0 + 64 + half * 32 + i * 8 + (lane_ >> 3)) * INW + h * 64 + (lane_ & 7) * 8);
        }
        f32x16 s[6];
#pragma unroll
        for (int kt = 0; kt < 6; ++kt) {
            s[kt] = (f32x16){};
#pragma unroll
            for (int d0 = 0; d0 < 4; ++d0) {
                const bf16x8 kfr = *(const LAS bf16x8*)(Ks + (ci * 64 + kt * 32 + q32) * MK_LD + d0 * 16 + hi * 8);
                s[kt] = __builtin_amdgcn_mfma_f32_32x32x16_bf16(kfr, qf[d0], s[kt], 0, 0, 0);
            }
        }
        const int jmin = c >= 2 ? 0 : 128 - 64 * c;
        float mx = -3.0e38f;
#pragma unroll
        for (int kt = 0; kt < 6; ++kt)
#pragma unroll
            for (int r = 0; r < 16; ++r) {
                float v = __builtin_fmaf(-slope2, __builtin_fabsf(relb - (float)(32 * kt + (r & 3) + 8 * (r >> 2))), s[kt][r]);
                if (c < 2) { const int j = 32 * kt + crow(r, hi); if (j < jmin) v = -1.0e30f; }
                s[kt][r] = v; mx = __builtin_fmaxf(mx, v);
            }
        mx = __builtin_fmaxf(mx, __shfl_xor(mx, 32));
        const float mm = __builtin_fmaxf(mx, sink2);
        float sum = 0.f;
#pragma unroll
        for (int kt = 0; kt < 6; ++kt)
#pragma unroll
            for (int r = 0; r < 16; ++r) { const float e = __builtin_amdgcn_exp2f(s[kt][r] - mm); s[kt][r] = e; sum += e; }
        sum += __shfl_xor(sum, 32);
        const float denom = sum + __builtin_amdgcn_exp2f(sink2 - mm);
        if (hi == 0) wsc[q32] = 1.0f / denom;
        f32x16 o[2]; o[0] = (f32x16){}; o[1] = (f32x16){};
#pragma unroll
        for (int kt = 0; kt < 6; ++kt)
#pragma unroll
            for (int jj = 0; jj < 2; ++jj) {
                u32x4 pw;
                pw.x = cvt_pk_bf16(s[kt][8 * jj + 0], s[kt][8 * jj + 1]); pw.y = cvt_pk_bf16(s[kt][8 * jj + 2], s[kt][8 * jj + 3]);
                pw.z = cvt_pk_bf16(s[kt][8 * jj + 4], s[kt][8 * jj + 5]); pw.w = cvt_pk_bf16(s[kt][8 * jj + 6], s[kt][8 * jj + 7]);
                const bf16x8 pa = __builtin_bit_cast(bf16x8, pw);
                const int e0 = 32 * kt + 16 * jj + 4 * hi;
#pragma unroll
                for (int db = 0; db < 2; ++db) {
                    const int sw = (((db * 32 + q32) >> 3) & 7) << 3;
                    const LAS bf16_t* vrow = Vt + (db * 32 + q32) * MV_LD + ci * 64;
                    const u32x2 lo = *(const LAS u32x2*)(vrow + (e0 ^ sw)), hi2 = *(const LAS u32x2*)(vrow + ((e0 + 8) ^ sw));
                    const bf16x8 vb = __builtin_bit_cast(bf16x8, (u32x4){lo.x, lo.y, hi2.x, hi2.y});
                    o[db] = __builtin_amdgcn_mfma_f32_32x32x16_bf16(pa, vb, o[db], 0, 0, 0);
                }
                __builtin_amdgcn_sched_barrier(0);
            }
        asm volatile("s_waitcnt lgkmcnt(0)" ::: "memory");
        LAS bf16_t* ost = (LAS bf16_t*)(lds + M_OST) + wid * (32 * 72);
#pragma unroll
        for (int r = 0; r < 16; ++r) {
            const int qq = crow(r, hi);
            const float inv = wsc[qq];
#pragma unroll
            for (int db = 0; db < 2; ++db) ost[qq * 72 + db * 32 + q32] = (bf16_t)(cvt_pk_bf16(o[db][r] * inv, 0.f) & 0xffffu);
        }
        asm volatile("s_waitcnt lgkmcnt(0)" ::: "memory");
#pragma unroll
        for (int i = 0; i < 4; ++i) {
            const int row = i * 8 + (lane >> 3), chn = lane & 7;
            const u32x4 v = *(const LAS u32x4*)(ost + row * 72 + chn * 8);
            *(u32x4*)(AD + (size_t)(row0 + half * 32 + row) * DM + h * 64 + chn * 8) = v;
        }
        asm volatile("s_waitcnt lgkmcnt(0)" ::: "memory");
    }
    {
        const int gl = tid >> 8, g = kvh * 2 + gl, rg = (tid >> 4) & 15, ch = tid & 15;
#pragma unroll 1
        for (int ci = 0; ci < 4; ++ci) {
            const int c = c0 + ci; const long row0 = rowb + (long)c * 64;
            if (g == 0) pool_task_prompt<2>(p, l, b, c, g, rg, ch, row0);
            else if (g == 1) pool_task_prompt<4>(p, l, b, c, g, rg, ch, row0);
            else if (g == 2) pool_task_prompt<8>(p, l, b, c, g, rg, ch, row0);
            else pool_task_prompt<16>(p, l, b, c, g, rg, ch, row0);
        }
    }
    __syncthreads();
}

__device__ __forceinline__ float wave_sum(float v) {
#pragma unroll
    for (int o = 1; o < 64; o <<= 1) v += __shfl_xor(v, o);
    return v;
}
__device__ __forceinline__ void transpose_item(const float* W, int N, const float* ks, bf16_t* WT, int ldo, int orow0, int k0, int n0, LAS float* scr, int lane) {
    f32x4 v[8];
#pragma unroll
    for (int i = 0; i < 8; ++i) v[i] = *(const f32x4*)(W + (size_t)(k0 + i * 4 + (lane >> 4)) * N + n0 + 4 * (lane & 15));
#pragma unroll
    for (int i = 0; i < 8; ++i) { const int kk = i * 4 + (lane >> 4); const float sc = ks ? ks[k0 + kk] : 1.0f; LAS float* d = scr + kk * 65 + 4 * (lane & 15);
        d[0] = v[i][0] * sc; d[1] = v[i][1] * sc; d[2] = v[i][2] * sc; d[3] = v[i][3] * sc; }
    asm volatile("s_waitcnt lgkmcnt(0)" ::: "memory");
    const int kc = lane & 3;
#pragma unroll
    for (int j = 0; j < 4; ++j) { const int n = (lane >> 2) + 16 * j; const LAS float* s = scr + (8 * kc) * 65 + n;
        u32x4 o; o.x = cvt_pk_bf16(s[0 * 65], s[1 * 65]); o.y = cvt_pk_bf16(s[2 * 65], s[3 * 65]); o.z = cvt_pk_bf16(s[4 * 65], s[5 * 65]); o.w = cvt_pk_bf16(s[6 * 65], s[7 * 65]);
        *(u32x4*)(WT + (size_t)(orow0 + n) * ldo + k0 + 8 * kc) = o; }
    asm volatile("s_waitcnt lgkmcnt(0)" ::: "memory");
}

constexpr int WI_IN = 32 * 52, WI_BA = 16 * 16, WI_OUT = 32 * 16, WI_UP = 32 * 88, WI_DN = 88 * 16, WI_L = WI_IN + WI_BA + WI_OUT + WI_UP + WI_DN;
__device__ __forceinline__ void convert_weights(const Params& p, LAS unsigned char* lds, int first, int last, int worker, int nworkers) {
    int tid = threadIdx.x; asm volatile("" : "+v"(tid));
    const int lane = tid & 63, wid = __builtin_amdgcn_readfirstlane(tid >> 6);
    LAS float* scr = (LAS float*)(lds + wid * 16384);
#pragma unroll 1
    for (int it = first + worker; it < last; it += nworkers) {
        const int l = it / WI_L; int r = it % WI_L;
        unsigned char* wb = p.ws + WS_W + (size_t)l * W_LAYER;
        if (r < WI_IN) { const int kb = r / 52, nb = r % 52; transpose_item(p.w_in + (size_t)l * DM * INW, INW, p.norm_mix + l * DM, (bf16_t*)(wb + WO_IN), DM, nb * 64, kb * 32, nb * 64, scr, lane); continue; } r -= WI_IN;
        if (r < WI_BA) { const int kb = r / 16, nb = r % 16; transpose_item(p.w_br_attn + (size_t)l * 512 * DM, DM, nullptr, (bf16_t*)(wb + WO_MIX), 512, nb * 64, kb * 32, nb * 64, scr, lane); continue; } r -= WI_BA;
        if (r < WI_OUT) { const int kb = r / 16, nb = r % 16; transpose_item(p.w_out + (size_t)l * DM * DM, DM, nullptr, (bf16_t*)(wb + WO_OUT), DM, nb * 64, kb * 32, nb * 64, scr, lane); continue; } r -= WI_OUT;
        if (r < WI_UP) { const int kb = r / 88, nb = r % 88; const int n0 = nb * 64; const int nn = n0 < FF ? n0 : n0 - FF; const int orow = (nn >> 7) * 256 + (n0 < FF ? 0 : 128) + (nn & 127);
            transpose_item(p.w_up + (size_t)l * DM * FF2, FF2, p.norm_ffn + l * DM, (bf16_t*)(wb + WO_UP), DM, orow, kb * 32, n0, scr, lane); continue; } r -= WI_UP;
        { const int kb = r / 16, nb = r % 16; transpose_item(p.w_down + (size_t)l * FF * DM, DM, nullptr, (bf16_t*)(wb + WO_DOWN), FF, nb * 64, kb * 32, nb * 64, scr, lane); }
    }
}
__device__ __forceinline__ void convert_weights_idle(const Params& p, LAS unsigned char* lds, int first, int last, int nwg, int G, int bx) {
    int tid = threadIdx.x; asm volatile("" : "+v"(tid));
    const int rem = nwg % G, wid = __builtin_amdgcn_readfirstlane(tid >> 6);
    if (bx >= rem) convert_weights(p, lds, first, last, (bx - rem) * 8 + wid, (G - rem) * 8);
}
__device__ __forceinline__ void prologue(const Params& p, LAS unsigned char* lds) {
    const int tid = threadIdx.x, lane = tid & 63, wid = __builtin_amdgcn_readfirstlane(tid >> 6);
    const int gt = blockIdx.x * 512 + tid, NGT = gridDim.x * 512;
    float* ssq = (float*)(p.ws + WS_SSQ);
    for (int i = gt; i < 3 * MPAD; i += NGT) ssq[MPAD + i] = 0.f;
    {
        const int gwv = blockIdx.x * 8 + wid, NGWV = gridDim.x * 8;
        for (int it = gwv; it < 2 * 1024; it += NGWV) {
            const int l = it >> 10, r = it & 1023, nblk = r & 15, kg = r >> 4, g = kg >> 4, c0 = (kg & 15) * 8, n = nblk * 64 + lane;
            const float* wp = p.w_pool + ((size_t)l * 4 + g) * 128 * 128 + (size_t)c0 * 128;
            const float* sc = p.pool_scale + l * 512 + g * 128;
            const float* wb = p.w_br_pool + (size_t)l * 512 * DM + (size_t)(g * 128) * DM + n;
            float a[8];
#pragma unroll
            for (int i = 0; i < 8; ++i) a[i] = 0.f;
#pragma unroll 8
            for (int d = 0; d < 128; ++d) { const float x = wb[(size_t)d * DM] * sc[d];
#pragma unroll
                for (int i = 0; i < 8; ++i) a[i] += wp[i * 128 + d] * x; }
            bf16_t* dst = (bf16_t*)(p.ws + WS_W + (size_t)l * W_LAYER + WO_MIX) + (size_t)(1024 + n) * 512 + g * 128 + c0;
            *(u32x4*)dst = pack8(a);
        }
    }
    convert_weights(p, lds, 0, WI_IN, blockIdx.x * 8 + wid, gridDim.x * 8);
    {
        bf16_t* XB = (bf16_t*)(p.ws + WS_XB);
        const int gw = blockIdx.x * 8 + wid, NGW = gridDim.x * 8;
#pragma unroll 1
        for (int m0 = gw; m0 < MREAL; m0 += 4 * NGW) {
            f32x4 v[4][4];
#pragma unroll
            for (int r = 0; r < 4; ++r) { const int m = m0 + r * NGW;
                if (m < MREAL) { const f32x4* xr = (const f32x4*)(m < MP ? p.xp + (size_t)m * DM : p.xs + (size_t)(m - MP) * DM) + lane;
#pragma unroll
                    for (int j = 0; j < 4; ++j) v[r][j] = xr[64 * j]; } }
#pragma unroll
            for (int r = 0; r < 4; ++r) { const int m = m0 + r * NGW;
                if (m < MREAL) { float s = 0.f; u32x2* o8 = (u32x2*)(XB + (size_t)m * DM) + lane;
#pragma unroll
                    for (int j = 0; j < 4; ++j) { s += (v[r][j][0] * v[r][j][0] + v[r][j][1] * v[r][j][1]) + (v[r][j][2] * v[r][j][2] + v[r][j][3] * v[r][j][3]);
                        u32x2 w; w.x = cvt_pk_bf16(v[r][j][0], v[r][j][1]); w.y = cvt_pk_bf16(v[r][j][2], v[r][j][3]); o8[64 * j] = w; }
                    s = wave_sum(s);
                    if (lane == 0) ssq[m] = s; } }
        }
    }
}

#define XB_TMO      128
#define XB_XCNT(j)  (256  + 64 * (j))
#define XB_XSUB(j)  (1280 + 64 * (j))
#define XB_XGEN(j)  (2304 + 64 * (j))
#define XB_TOP      3328
#define XB_TOPGEN   3392
#define XCD_BAR_WORDS 3456
#define XB_SPIN_CAP (1u << 18)
__device__ __forceinline__ unsigned xb_ld(unsigned* p)              { return __hip_atomic_load(p, __ATOMIC_RELAXED, __HIP_MEMORY_SCOPE_AGENT); }
__device__ __forceinline__ unsigned xb_add(unsigned* p, unsigned v) { return __hip_atomic_fetch_add(p, v, __ATOMIC_RELAXED, __HIP_MEMORY_SCOPE_AGENT); }
__device__ __forceinline__ unsigned xb_xcc_id() { return (unsigned)__builtin_amdgcn_s_getreg((3 << 11) | 20) & 0xFu; }
#define XB_SPIN(cond, bar) do { unsigned _sp = 0; while (cond) { __builtin_amdgcn_s_sleep(1); \
    if ((++_sp & 255u) == 0u) { if (xb_ld(&(bar)[XB_TMO])) break; if (_sp > XB_SPIN_CAP) { atomicAdd(&(bar)[XB_TMO], 1u); break; } } } } while (0)
struct XcdBarrier { unsigned* bar; unsigned x; volatile LAS unsigned* st; };
__device__ __forceinline__ XcdBarrier xcd_barrier_post(unsigned* bar, volatile LAS unsigned* st) {
    XcdBarrier b; b.bar = bar; b.x = xb_xcc_id(); b.st = st;
    if (threadIdx.x == 0) (void)xb_add(&bar[XB_XCNT(b.x)], 1u);
    return b;
}
__device__ __forceinline__ void xcd_barrier_complete(unsigned* bar, unsigned x, unsigned& nloc, unsigned& nx) {
    const unsigned G = gridDim.x * gridDim.y * gridDim.z;
    unsigned sum, cnt, mine, sp = 0u;
    for (;;) {
        sum = 0u; cnt = 0u; mine = 0u;
#pragma unroll
        for (unsigned j = 0; j < 16; ++j) { const unsigned c = xb_ld(&bar[XB_XCNT(j)]); sum += c; cnt += (c > 0u) ? 1u : 0u; mine = (j == x) ? c : mine; }
        if (sum == G) break;
        __builtin_amdgcn_s_sleep(1);
        if ((++sp & 255u) == 0u) { if (xb_ld(&bar[XB_TMO])) break; if (sp > XB_SPIN_CAP) { atomicAdd(&bar[XB_TMO], 1u); break; } }
    }
    nloc = mine > 0u ? mine : 1u; nx = cnt > 0u ? cnt : 1u;
}
__device__ __forceinline__ void xcd_barrier(const XcdBarrier& b) {
    asm volatile("s_waitcnt vmcnt(0)" ::: "memory");
    __syncthreads();
    if (threadIdx.x == 0) {
        unsigned* bar = b.bar;
        __builtin_amdgcn_s_waitcnt(0);
        unsigned nloc = b.st[0], nx = b.st[1];
        if (nloc == 0u) { xcd_barrier_complete(bar, b.x, nloc, nx); b.st[0] = nloc; b.st[1] = nx; }
        const unsigned old = xb_add(&bar[XB_XSUB(b.x)], 1u);
        const unsigned gen = old / nloc;
        if (old + 1u == (gen + 1u) * nloc) {
            __builtin_amdgcn_fence(__ATOMIC_RELEASE, "agent");
            asm volatile("s_waitcnt vmcnt(0)" ::: "memory");
            const unsigned og = xb_add(&bar[XB_TOP], 1u);
            const unsigned tg = og / nx;
            if (og + 1u == (tg + 1u) * nx) xb_add(&bar[XB_TOPGEN], 1u);
            else XB_SPIN(xb_ld(&bar[XB_TOPGEN]) == tg, bar);
            __builtin_amdgcn_fence(__ATOMIC_ACQUIRE, "agent");
            xb_add(&bar[XB_XGEN(b.x)], 1u);
            asm volatile("s_waitcnt vmcnt(0)" ::: "memory");
        } else {
            XB_SPIN(xb_ld(&bar[XB_XGEN(b.x)]) == gen, bar);
            __builtin_amdgcn_fence(__ATOMIC_ACQUIRE, "agent");
            asm volatile("s_waitcnt vmcnt(0)" ::: "memory");
        }
    }
    __syncthreads();
}


__global__ void __launch_bounds__(512) mk_fwd(Params p0) {
    extern __shared__ __attribute__((aligned(16))) unsigned char lds_raw[];
    LAS unsigned char* lds = (LAS unsigned char*)lds_raw;
    cg::grid_group grid = cg::this_grid();
    const int G = gridDim.x, bx = blockIdx.x;

    if (threadIdx.x < 2) ((volatile LAS unsigned*)(lds + MISC_OFF))[threadIdx.x] = 0u;
    {
        unsigned* bar = (unsigned*)(p0.ws + WS_BAR); unsigned* ready = bar + 4096;
        if (bx == 0) {
            for (int i = threadIdx.x; i < XCD_BAR_WORDS; i += 512) __hip_atomic_store(bar + i, 0u, __ATOMIC_RELAXED, __HIP_MEMORY_SCOPE_AGENT);
            asm volatile("s_waitcnt vmcnt(0)" ::: "memory");
            __syncthreads();
            if (threadIdx.x == 0) { __builtin_amdgcn_fence(__ATOMIC_RELEASE, "agent"); __hip_atomic_store(ready, 0x13572468u, __ATOMIC_RELAXED, __HIP_MEMORY_SCOPE_AGENT); }
        } else {
            if (threadIdx.x == 0) { unsigned sp = 0; while (__hip_atomic_load(ready, __ATOMIC_RELAXED, __HIP_MEMORY_SCOPE_AGENT) != 0x13572468u && ++sp < (1u << 22)) __builtin_amdgcn_s_sleep(2);
                                    __builtin_amdgcn_fence(__ATOMIC_ACQUIRE, "agent"); }
        }
        __syncthreads();
    }
    const XcdBarrier xbar = xcd_barrier_post((unsigned*)(p0.ws + WS_BAR), (volatile LAS unsigned*)(lds + MISC_OFF));
    if (p0.ws == nullptr) grid.sync();
    for (int rep = 0; rep < REP_P0; ++rep) { prologue(p0, lds); xcd_barrier(xbar); }
    for (int rep = 0; rep < EXTRA_SYNC; ++rep) xcd_barrier(xbar);

#pragma unroll 1
    for (int l = 0; l < 2; ++l) {
        Params p = p0;
        { unsigned char* w_ = p0.ws; float* o_ = p0.out; asm volatile("" : "+s"(w_), "+s"(o_)); p.ws = w_; p.out = o_; }
        float* ssq = (float*)(p.ws + WS_SSQ);
        bf16_t* XB = (bf16_t*)(p.ws + WS_XB); bf16_t* AD = (bf16_t*)(p.ws + WS_AD); bf16_t* MIX = (bf16_t*)(p.ws + WS_MIX); bf16_t* PROJ = (bf16_t*)(p.ws + WS_PROJ); bf16_t* U = PROJ;
        const unsigned char* wb = p.ws + WS_W + (size_t)l * W_LAYER;
        for (int rep = 0; rep < REP_P1; ++rep) {
            pg8::Gemm g{XB, (const bf16_t*)(wb + WO_IN), DM, DM, DM};
            small_proj(p, l, G, bx);
            SchedPlain S; S.o.init(MP / 256, INW / 256, G, bx); S.tA = 256L * DM * 2; S.tB = 256L * DM * 2;
            EpiProj E{PROJ, ssq + (2 * l) * MPAD, p.gate_bias + l * 2048};
            pg8::gemm_phase(lds, g, S, E);
            if (l == 0) convert_weights_idle(p, lds, WI_IN, WI_L, (MP / 256) * (INW / 256), G, bx);
        }
        xcd_barrier(xbar);
        for (int rep = 0; rep < REP_P2; ++rep) {
            const int vcu = (G % 8 == 0) ? (bx % 8) * (G / 8) + bx / 8 : bx;
#pragma unroll 1
            for (int idx = vcu; idx < 16 + 256; idx += G) {
                if (idx < 16) attn_unit(p, l, lds, true, idx >> 1, 0, idx & 1);
                else { const int q = idx - 16; attn_macro(p, l, lds, q >> 7, q & 63, (q >> 6) & 1); }
            }
            if (l == 0 && (vcu >= 16 || G <= 16)) { int tid_ = threadIdx.x; asm volatile("" : "+v"(tid_));
                const int nw = G > 16 ? G - 16 : G; convert_weights(p, lds, WI_L, 2 * WI_L, ((G > 16 ? vcu - 16 : vcu) * 8) + __builtin_amdgcn_readfirstlane(tid_ >> 6), nw * 8); }
        }
        xcd_barrier(xbar);
        for (int rep = 0; rep < REP_P3; ++rep) {
            pg8::Gemm g{AD, (const bf16_t*)(wb + WO_MIX), DM, 512, 512};
            small_mix(p, l, lds, G, bx);
            SchedMix S; S.o.init(MP / 256, DM / 256, G, bx);
            EpiMix E{MIX, PROJ};
            pg8::gemm_phase(lds, g, S, E);
        }
        xcd_barrier(xbar);
        {
            pg8::Gemm g{MIX, (const bf16_t*)(wb + WO_OUT), DM, DM, DM};
            SchedPlain S; S.o.init(MP / 256, DM / 256, G, bx); S.tA = 256L * DM * 2; S.tB = 256L * DM * 2;
            if (l == 0) { small_res<true, false, 4>(p, lds, MIX, DM, (const bf16_t*)(wb + WO_OUT), DM, ssq + (2 * l + 1) * MPAD, G, bx);
                          EpiRes<true, false> E{p.xp, p.out, XB, ssq + (2 * l + 1) * MPAD}; pg8::gemm_phase(lds, g, S, E); }
            else        { small_res<false, false, 4>(p, lds, MIX, DM, (const bf16_t*)(wb + WO_OUT), DM, ssq + (2 * l + 1) * MPAD, G, bx);
                          EpiRes<false, false> E{p.xp, p.out, XB, ssq + (2 * l + 1) * MPAD}; pg8::gemm_phase(lds, g, S, E); }
        }
        xcd_barrier(xbar);
        for (int rep = 0; rep < REP_P5; ++rep) {
            pg8::Gemm g{XB, (const bf16_t*)(wb + WO_UP), DM, DM, DM};
            small_up(p, l, G, bx);
            SchedPlain S; S.o.init(MP / 256, FF2 / 256, G, bx); S.tA = 256L * DM * 2; S.tB = 256L * DM * 2;
            EpiUpConv E{U, ssq + (2 * l + 1) * MPAD, p.conv_w + (size_t)l * 3 * FF2, p.conv_b + (size_t)l * FF2, p.out + O_CP + (size_t)l * 2 * 2 * FF2, (LAS float*)(lds + XCH_OFF), (float*)(p.ws + WS_HALO)};
            pg8::gemm_phase(lds, g, S, E);
        }
        xcd_barrier(xbar);
        {
            pg8::Gemm g{U, (const bf16_t*)(wb + WO_DOWN), FF, FF, FF};
            SchedPlain S; S.o.init(MP / 256, DM / 256, G, bx); S.tA = 256L * FF * 2; S.tB = 256L * FF * 2;
            { Unit uu; for (int i = 0; S.next(i, uu); ++i) conv_fixup(p, l, uu.pm); asm volatile("s_waitcnt vmcnt(0)" ::: "memory"); __syncthreads(); }
            for (int rep = 0; rep < DRY_P6; ++rep) { EpiNone E0{ssq}; pg8::gemm_phase(lds, g, S, E0); }
            if (l == 0) { small_res<false, false, 11>(p, lds, U, FF, (const bf16_t*)(wb + WO_DOWN), FF, ssq + 2 * MPAD, G, bx);
                          EpiRes<false, false> E{p.xp, p.out, XB, ssq + 2 * MPAD}; pg8::gemm_phase(lds, g, S, E); }
            else        { small_res<false, true, 11>(p, lds, U, FF, (const bf16_t*)(wb + WO_DOWN), FF, nullptr, G, bx);
                          EpiRes<false, true> E{p.xp, p.out, XB, nullptr}; pg8::gemm_phase(lds, g, S, E); }
        }
        if (l == 0) xcd_barrier(xbar);
    }
    if (bx == 0 && threadIdx.x == 0) __hip_atomic_store((unsigned*)(p0.ws + WS_BAR) + 4096, 0u, __ATOMIC_RELAXED, __HIP_MEMORY_SCOPE_AGENT);
}

extern "C" void kernel_launch(void* const* d_in, const int* in_sizes, int n_in, void* d_out, int out_size, void* d_ws, size_t ws_size, hipStream_t stream) {
    static int grid_blocks = 0;
    if (!grid_blocks) {
        int dev = 0, cus = 0, per_cu = 0;
        hipGetDevice(&dev);
        hipDeviceGetAttribute(&cus, hipDeviceAttributeMultiprocessorCount, dev);
        hipFuncSetAttribute((const void*)mk_fwd, hipFuncAttributeMaxDynamicSharedMemorySize, LDS_BYTES);
        hipOccupancyMaxActiveBlocksPerMultiprocessor(&per_cu, (const void*)mk_fwd, 512, LDS_BYTES);
        if (per_cu < 1) { fprintf(stderr, "kernel_launch: occupancy query reports %d blocks per CU\n", per_cu); per_cu = 1; }
        if (per_cu > 1) per_cu = 1;
        grid_blocks = cus * per_cu;
    }
    Params p{};
    const float** pp = (const float**)&p;
    for (int i = 0; i < 22; ++i) pp[i] = (const float*)d_in[i];
    p.out = (float*)d_out; p.ws = (unsigned char*)d_ws;
    void* args[] = {&p};
    hipError_t e = hipLaunchCooperativeKernel((const void*)mk_fwd, dim3(grid_blocks), dim3(512), args, LDS_BYTES, stream);
    if (e != hipSuccess) fprintf(stderr, "cooperative launch failed: %s (grid %d)\n", hipGetErrorString(e), grid_blocks);
}
```

```cpp
#include <hip/hip_runtime.h>
#include <hip/hip_cooperative_groups.h>
#include <cstdio>
#include <cstdint>
namespace cg = cooperative_groups;

#define LAS __attribute__((address_space(3)))
typedef unsigned short bf16_t;
typedef short bf16x8 __attribute__((ext_vector_type(8)));
typedef float f32x4 __attribute__((ext_vector_type(4)));
typedef float f32x2 __attribute__((ext_vector_type(2)));
typedef float f32x16 __attribute__((ext_vector_type(16)));
typedef unsigned u32x4 __attribute__((ext_vector_type(4)));
typedef unsigned u32x2 __attribute__((ext_vector_type(2)));

constexpr int DM = 1024, SEQ = 16384, NB = 2, MP = NB * SEQ, MS = 128, MREAL = MP + MS, MPAD = 33024;
constexpr int INW = 3328, FF = 2816, FF2 = 5632;
constexpr float EPS = 1e-6f, LOG2E = 1.4426950408889634f;
constexpr size_t O_Y = 0, O_KP = 33685504, O_VP = 33751040, O_PP = 33816576, O_CP = 33847296, O_KS = 33892352, O_VS = 34154496, O_PS = 34416640, O_CS = 34539520;
constexpr size_t MiB = 1u << 20;
constexpr size_t WS_SSQ = 0;
constexpr size_t WS_BAR = 768 * 1024;
constexpr int MISC_OFF = 147456 - 64;
constexpr size_t WS_W = 1 * MiB, W_LAYER = 27 * MiB;
constexpr size_t WO_IN = 0, WO_MIX = 6 * MiB + 512 * 1024, WO_OUT = WO_MIX + 2 * MiB, WO_UP = WO_OUT + 2 * MiB, WO_DOWN = WO_UP + 11 * MiB;
constexpr size_t WS_XB = 56 * MiB, WS_AD = 121 * MiB, WS_MIX = 186 * MiB, WS_PROJ = 251 * MiB;
constexpr size_t WS_HALO = 462 * MiB;
constexpr int LDS_BYTES = 147456, XCH_OFF = 131072;
#ifndef REP_P0
#define REP_P0 1
#endif
#ifndef REP_P1
#define REP_P1 1
#endif
#ifndef REP_P2
#define REP_P2 1
#endif
#ifndef REP_P3
#define REP_P3 1
#endif
#ifndef REP_P5
#define REP_P5 1
#endif
#ifndef DRY_P6
#define DRY_P6 0
#endif
#ifndef EXTRA_SYNC
#define EXTRA_SYNC 0
#endif

struct Params {
    const float *xp, *xs, *cache_k, *cache_v, *state_pool, *state_conv, *norm_mix, *w_in, *q_norm, *k_norm, *sinks, *w_pool, *pool_scale,
        *w_br_attn, *w_br_pool, *gate_bias, *w_out, *norm_ffn, *w_up, *conv_w, *conv_b, *w_down;
    float* out; unsigned char* ws;
};

__device__ __forceinline__ unsigned cvt_pk_bf16(float lo, float hi) { unsigned r; asm volatile("v_cvt_pk_bf16_f32 %0, %1, %2" : "=v"(r) : "v"(lo), "v"(hi)); return r; }
__device__ __forceinline__ float bf_lo(unsigned u) { return __builtin_bit_cast(float, u << 16); }
__device__ __forceinline__ float bf_hi(unsigned u) { return __builtin_bit_cast(float, u & 0xffff0000u); }
__device__ __forceinline__ void unpack8(const u32x4 w, float* f) { f[0] = bf_lo(w.x); f[1] = bf_hi(w.x); f[2] = bf_lo(w.y); f[3] = bf_hi(w.y); f[4] = bf_lo(w.z); f[5] = bf_hi(w.z); f[6] = bf_lo(w.w); f[7] = bf_hi(w.w); }
__device__ __forceinline__ u32x4 pack8(const float* f) { u32x4 w; w.x = cvt_pk_bf16(f[0], f[1]); w.y = cvt_pk_bf16(f[2], f[3]); w.z = cvt_pk_bf16(f[4], f[5]); w.w = cvt_pk_bf16(f[6], f[7]); return w; }
__device__ __forceinline__ float ror1(float x) { return __builtin_bit_cast(float, __builtin_amdgcn_update_dpp(0, __builtin_bit_cast(int, x), 0x121, 0xf, 0xf, false)); }
__device__ __forceinline__ float ror2(float x) { return __builtin_bit_cast(float, __builtin_amdgcn_update_dpp(0, __builtin_bit_cast(int, x), 0x122, 0xf, 0xf, false)); }
__device__ __forceinline__ f32x2 gelu_pk(f32x2 v) {
    const f32x2 av = __builtin_elementwise_abs(v), d = av * 0.2316418882f + 1.0f;
    f32x2 t; t.x = __builtin_amdgcn_rcpf(d.x); t.y = __builtin_amdgcn_rcpf(d.y);
    f32x2 q = t * 0.5307027145f + (-0.7265760135f); q = q * t + 0.7107068705f; q = q * t + (-0.142248368f); q = q * t + 0.127414796f; q = q * t;
    const f32x2 s = (v * v) * (-0.72134752044f);
    f32x2 e; e.x = __builtin_amdgcn_exp2f(s.x); e.y = __builtin_amdgcn_exp2f(s.y);
    const f32x2 m = v * (q * e), r = v - m;
    f32x2 o; o.x = v.x < 0.f ? m.x : r.x; o.y = v.y < 0.f ? m.y : r.y; return o;
}

namespace pg8 {
constexpr int BM = 256, BK = 64, HALF = 128, HTB = HALF * BK * 2, STAGE_BYTES = 8 * HTB, NXCD = 8, WGM = 8;
__host__ __device__ __forceinline__ int lds_byte(int r, int c) { const int st = (r >> 4) * 2 + (c >> 5), rr = r & 15, cc = c & 31, ob = rr * 64 + cc * 2; return st * 1024 + (ob ^ (((ob >> 9) & 1) << 5)); }
__host__ __device__ __forceinline__ void stage_rc(int b, int& R, int& C) { const int st = b / 1024, sb = b % 1024, swz = sb ^ (((sb >> 9) & 1) << 5); R = (st >> 1) * 16 + swz / 64; C = (st & 1) * 32 + (swz % 64) / 2; }
__host__ __device__ __forceinline__ int perm32(int rho) { const int n = rho >> 4, i = rho & 15; return 8 * (i >> 2) + 4 * n + (i & 3); }

struct Unit { int pm, pn, z; };
struct Gemm { const bf16_t* A; const bf16_t* Bt; int lda, ldb, K; };

struct TileOrder {
    int nM, nN, nwg, G, c;
    __device__ void init(int nM_, int nN_, int G_, int c_) { nM = nM_; nN = nN_; nwg = nM * nN; G = G_; c = c_; }
    __device__ bool tile(int i, Unit& u) const {
        const long L = (long)i * G + c; if (L >= nwg) return false;
        int wgid = (int)L; { const int q = nwg / NXCD, r = nwg % NXCD, xcd = wgid % NXCD, off = wgid / NXCD; wgid = (xcd < r ? xcd * (q + 1) : r * (q + 1) + (xcd - r) * q) + off; }
        const int nig = WGM * nN, gid = wgid / nig, fm = gid * WGM, gsz = (nM - fm) < WGM ? (nM - fm) : WGM;
        u.pm = fm + ((wgid % nig) % gsz); u.pn = (wgid % nig) / gsz; return true;
    }
};

template <class E> __device__ __forceinline__ auto epi_keep_acc(const E& e, const Unit& u) -> decltype(e.keep_acc(u)) { return e.keep_acc(u); }
__device__ __forceinline__ bool epi_keep_acc(...) { return false; }
template <class Epi, class Sched>
__device__ __forceinline__ void gemm_phase(LAS unsigned char* lds, const Gemm g, const Sched& S, const Epi& E) {
    int tid = threadIdx.x; asm volatile("" : "+v"(tid));
    const int wid = __builtin_amdgcn_readfirstlane(tid >> 6), lane = tid & 63, wr = wid >> 2, wc = wid & 3, fr = lane & 15, fq = lane >> 4;
    const int K = g.K, nt = K / BK;
    unsigned voffA[2], voffB[2];
#pragma unroll
    for (int i = 0; i < 2; ++i) { int R, C; stage_rc(tid * 16 + i * 8192, R, C); const int Rb = Epi::PERM ? ((R & ~31) + perm32(R & 31)) : R;
        voffA[i] = (unsigned)(R * g.lda + C) * 2u; voffB[i] = (unsigned)(Rb * g.ldb + C) * 2u; }
    const size_t kstep = (size_t)(BK * 2);
    const size_t hstepA = (size_t)HALF * g.lda * 2, hstepB = (size_t)HALF * g.ldb * 2;
    const unsigned ldsw = (unsigned)wid * 1024u;
    const int aoff = lds_byte(wr * 64 + fr, fq * 8), boff = lds_byte(wc * 32 + fr, fq * 8);
#define PG8_SA(b, h) (((b) * 2 + (h)) * HTB)
#define PG8_SB(b, h) ((4 + (b) * 2 + (h)) * HTB)
#define PG8_STAGE(bufoff, gbase, voff) do { _Pragma("unroll") for (int _i = 0; _i < 2; ++_i) \
        __builtin_amdgcn_global_load_lds((const unsigned*)((const char*)(gbase) + (voff)[_i]), (LAS unsigned*)(lds + (bufoff) + ldsw + _i * 8192), 16, 0, 0); } while (0)
#define PG8_LDA(dst, b, h) do { _Pragma("unroll") for (int m = 0; m < 4; ++m) _Pragma("unroll") for (int k = 0; k < 2; ++k) dst[m][k] = *(const LAS bf16x8*)(lds + PG8_SA(b, h) + aoff + m * 2048 + k * 1024); } while (0)
#define PG8_LDB(dst, b, h) do { _Pragma("unroll") for (int n = 0; n < 2; ++n) _Pragma("unroll") for (int k = 0; k < 2; ++k) dst[n][k] = *(const LAS bf16x8*)(lds + PG8_SB(b, h) + boff + n * 2048 + k * 1024); } while (0)
#define PG8_MMA(ai, bj, At, Bt) do { __builtin_amdgcn_s_setprio(1); _Pragma("unroll") for (int m = 0; m < 4; ++m) _Pragma("unroll") for (int n = 0; n < 2; ++n) _Pragma("unroll") for (int k = 0; k < 2; ++k) \
        acc[ai][bj][m][n] = __builtin_amdgcn_mfma_f32_16x16x32_bf16(Bt[n][k], At[m][k], acc[ai][bj][m][n], 0, 0, 0); __builtin_amdgcn_s_setprio(0); } while (0)
#define PG8_WAIT_V(n) asm volatile("s_waitcnt vmcnt(" #n ")" ::: "memory")
#define PG8_WAIT_L(n) asm volatile("s_waitcnt lgkmcnt(" #n ")" ::: "memory")
#define PG8_BAR __builtin_amdgcn_s_barrier()
#define PG8_SCHED __builtin_amdgcn_sched_barrier(0)
    Unit cur, nxt; int ui = 0;
    if (!S.next(0, cur)) return;
    f32x4 acc[2][2][4][2];
#pragma unroll
    for (int a = 0; a < 2; ++a)
#pragma unroll
        for (int b = 0; b < 2; ++b)
#pragma unroll
            for (int m = 0; m < 4; ++m)
#pragma unroll
                for (int n = 0; n < 2; ++n) acc[a][b][m][n] = (f32x4){0.f, 0.f, 0.f, 0.f};
    bf16x8 At[4][2], B0[2][2], B1[2][2];
    const char* cA = (const char*)g.A + S.a_off(cur); const char* cB = (const char*)g.Bt + S.b_off(cur);
    PG8_STAGE(PG8_SB(0, 0), cB, voffB); PG8_STAGE(PG8_SB(0, 1), cB + hstepB, voffB); PG8_STAGE(PG8_SA(0, 0), cA, voffA); PG8_STAGE(PG8_SA(0, 1), cA + hstepA, voffA);
    if (wr == 1) PG8_BAR;
    PG8_WAIT_V(2); PG8_BAR;
    PG8_STAGE(PG8_SB(1, 0), cB + kstep, voffB); PG8_STAGE(PG8_SA(1, 0), cA + kstep, voffA); PG8_STAGE(PG8_SB(1, 1), cB + hstepB + kstep, voffB);
    PG8_WAIT_V(6); PG8_BAR;
    for (;;) {
        const bool has_next = S.next(ui + 1, nxt);
        const char* nA = has_next ? (const char*)g.A + S.a_off(nxt) : cA; const char* nB = has_next ? (const char*)g.Bt + S.b_off(nxt) : cB;
        for (int t = 0; t < nt; t += 2) {
            const bool last = (t == nt - 2);
            const char* a1 = cA + (size_t)(t + 1) * kstep;
            const char* a2 = last ? nA : cA + (size_t)(t + 2) * kstep; const char* b2 = last ? nB : cB + (size_t)(t + 2) * kstep;
            const char* a3 = a2 + kstep; const char* b3 = b2 + kstep;
            PG8_LDB(B0, 0, 0); PG8_LDB(B1, 0, 1); PG8_SCHED; PG8_LDA(At, 0, 0); PG8_STAGE(PG8_SA(1, 1), a1 + hstepA, voffA);
            PG8_WAIT_V(8); PG8_WAIT_L(0); PG8_BAR; PG8_MMA(0, 0, At, B0); PG8_MMA(0, 1, At, B1); PG8_BAR; PG8_SCHED;
            PG8_LDA(At, 0, 1); PG8_STAGE(PG8_SB(0, 0), b2, voffB); PG8_STAGE(PG8_SB(0, 1), b2 + hstepB, voffB); PG8_STAGE(PG8_SA(0, 0), a2, voffA);
            PG8_WAIT_V(8); PG8_WAIT_L(0); PG8_BAR; PG8_MMA(1, 0, At, B0); PG8_MMA(1, 1, At, B1); PG8_BAR; PG8_SCHED;
            PG8_LDB(B0, 1, 0); PG8_LDB(B1, 1, 1); PG8_SCHED; PG8_LDA(At, 1, 0); PG8_STAGE(PG8_SA(0, 1), a2 + hstepA, voffA);
            PG8_WAIT_V(8); PG8_WAIT_L(0); PG8_BAR; PG8_MMA(0, 0, At, B0); PG8_MMA(0, 1, At, B1); PG8_BAR; PG8_SCHED;
            PG8_LDA(At, 1, 1); PG8_STAGE(PG8_SB(1, 0), b3, voffB); PG8_STAGE(PG8_SB(1, 1), b3 + hstepB, voffB); PG8_STAGE(PG8_SA(1, 0), a3, voffA);
            PG8_WAIT_V(8); PG8_WAIT_L(0); PG8_BAR; PG8_MMA(1, 0, At, B0); PG8_MMA(1, 1, At, B1); PG8_BAR; PG8_SCHED;
        }
        if (wr == 0) PG8_BAR;
        { int fr_ = fr, fq_ = fq; asm volatile("" : "+v"(fr_), "+v"(fq_));
          E(acc, cur, wr, wc, fr_, fq_); }
        if (!has_next) break;
        if (!epi_keep_acc(E, cur)) {
#pragma unroll
        for (int a = 0; a < 2; ++a)
#pragma unroll
            for (int b = 0; b < 2; ++b)
#pragma unroll
                for (int m = 0; m < 4; ++m)
#pragma unroll
                    for (int n = 0; n < 2; ++n) acc[a][b][m][n] = (f32x4){0.f, 0.f, 0.f, 0.f};
        }
        cur = nxt; cA = nA; cB = nB; ++ui;
        if (wr == 1) PG8_BAR;
    }
    PG8_WAIT_V(0);
    PG8_BAR;
#undef PG8_SA
#undef PG8_SB
#undef PG8_STAGE
#undef PG8_LDA
#undef PG8_LDB
#undef PG8_MMA
#undef PG8_WAIT_V
#undef PG8_WAIT_L
#undef PG8_BAR
#undef PG8_SCHED
}
}
using pg8::Unit;
typedef f32x4 AccT[2][2][4][2];

struct SchedPlain {
    pg8::TileOrder o; long tA, tB;
    __device__ __forceinline__ bool next(int i, Unit& u) const { u.z = 0; return o.tile(i, u); }
    __device__ __forceinline__ long a_off(const Unit& u) const { return (long)u.pm * tA; }
    __device__ __forceinline__ long b_off(const Unit& u) const { return (long)u.pn * tB; }
};
struct SchedMix {
    pg8::TileOrder o;
    __device__ __forceinline__ bool next(int i, Unit& u) const { u.z = i & 1; return o.tile(i >> 1, u); }
    __device__ __forceinline__ long a_off(const Unit& u) const { return (long)u.pm * 256 * DM * 2 + (long)u.z * 512 * 2; }
    __device__ __forceinline__ long b_off(const Unit& u) const { return ((long)u.z * 1024 + (long)u.pn * 256) * 512 * 2; }
};
struct SchedUp {
    pg8::TileOrder o;
    __device__ __forceinline__ bool next(int i, Unit& u) const { u.z = 0; return o.tile(i, u); }
    __device__ __forceinline__ long a_off(const Unit& u) const { const int ti = u.pm; const int b = ti / 65, i = ti % 65; return ((long)b * SEQ + 254 * i - 2) * DM * 2; }
    __device__ __forceinline__ long b_off(const Unit& u) const { return (long)u.pn * 256 * DM * 2; }
};

struct EpiProj {
    static constexpr bool PERM = true;
    bf16_t* P; const float* ssq; const float* gbias;
    __device__ __forceinline__ void operator()(AccT& acc, const Unit& u, int wr, int wc, int fr, int fq) const {
        const bool gate = u.pn >= 5;
        const int col0 = u.pn * 256 + wc * 32 + 8 * fq;
        f32x4 gb[2][2];
#pragma unroll
        for (int bj = 0; bj < 2; ++bj)
#pragma unroll
            for (int n = 0; n < 2; ++n) gb[bj][n] = gate ? *(const f32x4*)(gbias + (col0 - 1280) + bj * 128 + 4 * n) : (f32x4){0.f, 0.f, 0.f, 0.f};
        float rsv[2][4];
#pragma unroll
        for (int ai = 0; ai < 2; ++ai)
#pragma unroll
            for (int m = 0; m < 4; ++m) rsv[ai][m] = ssq[u.pm * 256 + ai * 128 + wr * 64 + m * 16 + fr];
#pragma unroll
        for (int ai = 0; ai < 2; ++ai)
#pragma unroll
            for (int m = 0; m < 4; ++m) {
                const int row = u.pm * 256 + ai * 128 + wr * 64 + m * 16 + fr;
                const float rs = __builtin_amdgcn_rsqf(rsv[ai][m] * (1.0f / 1024.0f) + EPS);
                bf16_t* rowp = P + (size_t)row * INW + col0;
#pragma unroll
                for (int bj = 0; bj < 2; ++bj) {
                    float v[8];
#pragma unroll
                    for (int n = 0; n < 2; ++n)
#pragma unroll
                        for (int j = 0; j < 4; ++j) {
                            float x = acc[ai][bj][m][n][j] * rs;
                            if (gate) { x += gb[bj][n][j]; x = __builtin_amdgcn_rcpf(1.0f + __builtin_amdgcn_exp2f(-LOG2E * x)); }
                            v[n * 4 + j] = x;
                        }
                    *(u32x4*)(rowp + bj * 128) = pack8(v);
                }
            }
    }
};
struct EpiMix {
    static constexpr bool PERM = true;
    bf16_t* MIX; const bf16_t* P;
    __device__ __forceinline__ bool keep_acc(const Unit& u) const { return u.z == 0; }
    __device__ __forceinline__ void operator()(AccT& acc, const Unit& u, int wr, int wc, int fr, int fq) const {
        const int col0 = u.pn * 256 + wc * 32 + 8 * fq;
        const char* Pb = (const char*)P;
        u32x4 gw[2][4][2];
        if (u.z == 0) {
#pragma unroll
            for (int ai = 0; ai < 2; ++ai)
#pragma unroll
                for (int m = 0; m < 4; ++m)
#pragma unroll
                    for (int bj = 0; bj < 2; ++bj) gw[ai][m][bj] = *(const u32x4*)(Pb + (unsigned)(((u.pm * 256 + ai * 128 + wr * 64 + m * 16 + fr) * INW + col0 + bj * 128 + 1280) * 2));
#pragma unroll
            for (int ai = 0; ai < 2; ++ai)
#pragma unroll
                for (int m = 0; m < 4; ++m)
#pragma unroll
                    for (int bj = 0; bj < 2; ++bj) { float g0[8]; unpack8(gw[ai][m][bj], g0);
#pragma unroll
                        for (int n = 0; n < 2; ++n)
#pragma unroll
                            for (int j = 0; j < 4; ++j) acc[ai][bj][m][n][j] *= g0[n * 4 + j]; }
        }
#pragma unroll
        for (int ai = 0; ai < 2; ++ai)
#pragma unroll
            for (int m = 0; m < 4; ++m)
#pragma unroll
                for (int bj = 0; bj < 2; ++bj) gw[ai][m][bj] = *(const u32x4*)(Pb + (unsigned)(((u.pm * 256 + ai * 128 + wr * 64 + m * 16 + fr) * INW + col0 + bj * 128 + 2304) * 2));
#pragma unroll
        for (int ai = 0; ai < 2; ++ai)
#pragma unroll
            for (int m = 0; m < 4; ++m)
#pragma unroll
                for (int bj = 0; bj < 2; ++bj) {
                    const int row = u.pm * 256 + ai * 128 + wr * 64 + m * 16 + fr, col = col0 + bj * 128;
                    float g1[8]; unpack8(gw[ai][m][bj], g1);
                    if (u.z == 0) {
#pragma unroll
                        for (int n = 0; n < 2; ++n)
#pragma unroll
                            for (int j = 0; j < 4; ++j) acc[ai][bj][m][n][j] *= __builtin_amdgcn_rcpf(__builtin_fmaxf(g1[n * 4 + j], 1.0e-30f));
                    } else {
                        float v[8];
#pragma unroll
                        for (int n = 0; n < 2; ++n)
#pragma unroll
                            for (int j = 0; j < 4; ++j) v[n * 4 + j] = acc[ai][bj][m][n][j] * g1[n * 4 + j];
                        *(u32x4*)((char*)MIX + (unsigned)((row * DM + col) * 2)) = pack8(v);
                    }
                }
    }
};
template <bool RES_F32, bool OUT_F32> struct EpiRes {
    static constexpr bool PERM = true;
    const float* res; float* out; bf16_t* XB; float* ssq_next;
    __device__ __forceinline__ void finish(const f32x4 x0, const f32x4 x1, int row, int col, float& s) const {
        if (OUT_F32) { *(f32x4*)(out + (size_t)row * DM + col) = x0; *(f32x4*)(out + (size_t)row * DM + col + 4) = x1; }
        else { u32x4 w; w.x = cvt_pk_bf16(x0[0], x0[1]); w.y = cvt_pk_bf16(x0[2], x0[3]); w.z = cvt_pk_bf16(x1[0], x1[1]); w.w = cvt_pk_bf16(x1[2], x1[3]); *(u32x4*)(XB + (size_t)row * DM + col) = w; }
        s += (x0[0] * x0[0] + x0[1] * x0[1]) + (x0[2] * x0[2] + x0[3] * x0[3]) + (x1[0] * x1[0] + x1[1] * x1[1]) + (x1[2] * x1[2] + x1[3] * x1[3]);
    }
    __device__ __forceinline__ void operator()(AccT& acc, const Unit& u, int wr, int wc, int fr, int fq) const {
        const int col0 = u.pn * 256 + wc * 32 + 8 * fq;
        if constexpr (!RES_F32) {
            u32x4 rb[2][4][2];
#pragma unroll
            for (int ai = 0; ai < 2; ++ai)
#pragma unroll
                for (int m = 0; m < 4; ++m)
#pragma unroll
                    for (int bj = 0; bj < 2; ++bj) rb[ai][m][bj] = *(const u32x4*)((const char*)XB + (unsigned)(((u.pm * 256 + ai * 128 + wr * 64 + m * 16 + fr) * DM + col0 + bj * 128) * 2));
#pragma unroll
            for (int ai = 0; ai < 2; ++ai)
#pragma unroll
                for (int m = 0; m < 4; ++m) {
                    const int row = u.pm * 256 + ai * 128 + wr * 64 + m * 16 + fr; float s = 0.f;
#pragma unroll
                    for (int bj = 0; bj < 2; ++bj) { const u32x4 w = rb[ai][m][bj];
                        finish((f32x4){bf_lo(w.x), bf_hi(w.x), bf_lo(w.y), bf_hi(w.y)} + acc[ai][bj][m][0], (f32x4){bf_lo(w.z), bf_hi(w.z), bf_lo(w.w), bf_hi(w.w)} + acc[ai][bj][m][1], row, col0 + bj * 128, s); }
                    if (!OUT_F32) { s += __shfl_xor(s, 16); s += __shfl_xor(s, 32); if (fq == 0) atomicAdd(ssq_next + row, s); }
                }
        } else {
#pragma unroll
            for (int ai = 0; ai < 2; ++ai) {
                f32x4 rv[4][2][2];
#pragma unroll
                for (int m = 0; m < 4; ++m)
#pragma unroll
                    for (int bj = 0; bj < 2; ++bj) { const size_t o = (size_t)(u.pm * 256 + ai * 128 + wr * 64 + m * 16 + fr) * DM + col0 + bj * 128; rv[m][bj][0] = *(const f32x4*)(res + o); rv[m][bj][1] = *(const f32x4*)(res + o + 4); }
#pragma unroll
                for (int m = 0; m < 4; ++m) {
                    const int row = u.pm * 256 + ai * 128 + wr * 64 + m * 16 + fr; float s = 0.f;
#pragma unroll
                    for (int bj = 0; bj < 2; ++bj) finish(rv[m][bj][0] + acc[ai][bj][m][0], rv[m][bj][1] + acc[ai][bj][m][1], row, col0 + bj * 128, s);
                    if (!OUT_F32) { s += __shfl_xor(s, 16); s += __shfl_xor(s, 32); if (fq == 0) atomicAdd(ssq_next + row, s); }
                }
            }
        }
    }
};
struct EpiNone { static constexpr bool PERM = true; __device__ __forceinline__ void operator()(AccT& acc, const Unit& u, int wr, int wc, int fr, int fq) const { float s = 0.f;
#pragma unroll
        for (int ai = 0; ai < 2; ++ai)
#pragma unroll
            for (int bj = 0; bj < 2; ++bj)
#pragma unroll
                for (int m = 0; m < 4; ++m)
#pragma unroll
                    for (int n = 0; n < 2; ++n) s += acc[ai][bj][m][n][0] + acc[ai][bj][m][n][1] + acc[ai][bj][m][n][2] + acc[ai][bj][m][n][3];
        if (s == 123.456f) *sink = s; }
    float* sink; };
struct EpiUpConv {
    static constexpr bool PERM = true;
    bf16_t* U; const float* ssq; const float* cw; const float* cb; float* conv_p; LAS float* xch; float* halo;
    __device__ __forceinline__ void operator()(AccT& acc, const Unit& u, int wr, int wc, int fr, int fq) const {
        const int b = u.pm >> 6, tstart = (u.pm & 63) * 256;
        const long arow0 = (long)u.pm * 256;
        const int colg0 = u.pn * 128 + wc * 32 + fq * 8;
        f32x4 cwg[2][3], cwv[2][3], cbg[2], cbv[2];
#pragma unroll
        for (int n = 0; n < 1; ++n) { const int colg = colg0 + n * 4, colv = FF + colg;
#pragma unroll
            for (int j = 0; j < 3; ++j) { cwg[n][j] = *(const f32x4*)(cw + j * FF2 + colg); cwv[n][j] = *(const f32x4*)(cw + j * FF2 + colv); }
            cbg[n] = *(const f32x4*)(cb + colg); cbv[n] = *(const f32x4*)(cb + colv); }
        float sq[2][4];
#pragma unroll
        for (int ai = 0; ai < 2; ++ai)
#pragma unroll
            for (int m = 0; m < 4; ++m) { const int rl = ai * 128 + wr * 64 + m * 16 + fr, t = tstart + rl; sq[ai][m] = ssq[arow0 + rl]; }
#pragma unroll
        for (int ai = 0; ai < 2; ++ai)
#pragma unroll
            for (int m = 0; m < 4; ++m) {
                const int rl = ai * 128 + wr * 64 + m * 16 + fr;
                const int t = tstart + rl;
                const float rs = __builtin_amdgcn_rsqf(sq[ai][m] * (1.0f / 1024.0f) + EPS);
#pragma unroll
                for (int bj = 0; bj < 2; ++bj)
#pragma unroll
                    for (int n = 0; n < 2; ++n) acc[ai][bj][m][n] = acc[ai][bj][m][n] * rs;
            }
        if (fr >= 14) {
#pragma unroll
            for (int ai = 0; ai < 2; ++ai)
#pragma unroll
                for (int bj = 0; bj < 2; ++bj)
#pragma unroll
                    for (int n = 0; n < 2; ++n)
                        *(LAS f32x4*)(xch + (((ai * 2 + wr) * 2 + (fr - 14)) * 256 + bj * 128 + wc * 32 + fq * 8 + n * 4)) = acc[ai][bj][3][n];
        }
        asm volatile("s_waitcnt lgkmcnt(0)" ::: "memory"); __builtin_amdgcn_s_barrier(); asm volatile("" ::: "memory");
        u32x2 stash[2][4];
#pragma unroll
        for (int n = 0; n < 2; ++n) {
            const int colg = colg0 + n * 4, colv = FF + colg;
            if (n == 1) {
#pragma unroll
                for (int j = 0; j < 3; ++j) { cwg[1][j] = *(const f32x4*)(cw + j * FF2 + colg); cwv[1][j] = *(const f32x4*)(cw + j * FF2 + colv); }
                cbg[1] = *(const f32x4*)(cb + colg); cbv[1] = *(const f32x4*)(cb + colv); }
            const f32x4 w0g = cwg[n][0], w1g = cwg[n][1], w2g = cwg[n][2], bg = cbg[n];
            const f32x4 w0v = cwv[n][0], w1v = cwv[n][1], w2v = cwv[n][2], bv = cbv[n];
#pragma unroll
            for (int ai = 0; ai < 2; ++ai) {
                f32x4 hg = (f32x4){0.f, 0.f, 0.f, 0.f}, hv = hg;
                const int s = ai * 2 + wr;
                if (s > 0 && fr >= 14) {
                    hg = *(const LAS f32x4*)(xch + (((s - 1) * 2 + (fr - 14)) * 256 + wc * 32 + fq * 8 + n * 4));
                    hv = *(const LAS f32x4*)(xch + (((s - 1) * 2 + (fr - 14)) * 256 + 128 + wc * 32 + fq * 8 + n * 4));
                }
#pragma unroll
                for (int m = 0; m < 4; ++m) {
                    const int rl = ai * 128 + wr * 64 + m * 16 + fr;
                    const f32x4 cg_ = acc[ai][0][m][n], cv_ = acc[ai][1][m][n];
                    f32x4 p1g, p2g, p1v, p2v;
#pragma unroll
                    for (int j = 0; j < 4; ++j) {
                        p1g[j] = ror1(fr == 15 ? hg[j] : cg_[j]); p2g[j] = ror2(fr >= 14 ? hg[j] : cg_[j]);
                        p1v[j] = ror1(fr == 15 ? hv[j] : cv_[j]); p2v[j] = ror2(fr >= 14 ? hv[j] : cv_[j]);
                    }
                    const f32x4 hcg = bg + w0g * p2g + w1g * p1g + w2g * cg_;
                    const f32x4 hcv = bv + w0v * p2v + w1v * p1v + w2v * cv_;
                    const f32x2 ga = gelu_pk((f32x2){hcg[0], hcg[1]}), gb2 = gelu_pk((f32x2){hcg[2], hcg[3]});
                    u32x2 w; w.x = cvt_pk_bf16(ga.x * hcv[0], ga.y * hcv[1]); w.y = cvt_pk_bf16(gb2.x * hcv[2], gb2.y * hcv[3]);
                    const int t = tstart + rl;
                    if (n == 0) stash[ai][m] = w;
                    else if (rl >= 2) *(u32x4*)(U + (size_t)(arow0 + rl) * FF + colg0) = (u32x4){stash[ai][m].x, stash[ai][m].y, w.x, w.y};
                    if (rl < 2 || rl >= 254) { float* hp = halo + ((size_t)u.pm * 4 + (rl < 2 ? rl : rl - 252)) * FF2; *(f32x4*)(hp + colg) = cg_; *(f32x4*)(hp + colv) = cv_; }
                    if (t >= SEQ - 2) { float* cp = conv_p + (size_t)(b * 2 + (t - (SEQ - 2))) * FF2; *(f32x4*)(cp + colg) = cg_; *(f32x4*)(cp + colv) = cv_; }
                    hg = cg_; hv = cv_;
                    __builtin_amdgcn_sched_barrier(0);
                }
            }
        }
    }
};


__device__ __forceinline__ void conv_fixup(const Params& p, int l, int pm) {
    int tid = threadIdx.x; asm volatile("" : "+v"(tid));
    const float* halo = (const float*)(p.ws + WS_HALO); bf16_t* U = (bf16_t*)(p.ws + WS_PROJ);
    const float* cw = p.conv_w + (size_t)l * 3 * FF2; const float* cb = p.conv_b + (size_t)l * FF2;
    const bool first = (pm & 63) == 0;
#pragma unroll 1
    for (int q = tid; q < FF / 4; q += 512) {
        const int cg = 4 * q, cv = FF + cg;
        const f32x4 z = (f32x4){0.f, 0.f, 0.f, 0.f};
        const float* hp = halo + (size_t)(pm - 1) * 4 * FF2; const float* hc_ = halo + (size_t)pm * 4 * FF2;
        const f32x4 a2g = first ? z : *(const f32x4*)(hp + 2 * FF2 + cg), a2v = first ? z : *(const f32x4*)(hp + 2 * FF2 + cv);
        const f32x4 a1g = first ? z : *(const f32x4*)(hp + 3 * FF2 + cg), a1v = first ? z : *(const f32x4*)(hp + 3 * FF2 + cv);
        const f32x4 r0g = *(const f32x4*)(hc_ + cg), r0v = *(const f32x4*)(hc_ + cv), r1g = *(const f32x4*)(hc_ + FF2 + cg), r1v = *(const f32x4*)(hc_ + FF2 + cv);
        const f32x4 w0g = *(const f32x4*)(cw + cg), w1g = *(const f32x4*)(cw + FF2 + cg), w2g = *(const f32x4*)(cw + 2 * FF2 + cg), bg = *(const f32x4*)(cb + cg);
        const f32x4 w0v = *(const f32x4*)(cw + cv), w1v = *(const f32x4*)(cw + FF2 + cv), w2v = *(const f32x4*)(cw + 2 * FF2 + cv), bv = *(const f32x4*)(cb + cv);
#pragma unroll
        for (int r = 0; r < 2; ++r) {
            const f32x4 hcg = bg + w0g * (r == 0 ? a2g : a1g) + w1g * (r == 0 ? a1g : r0g) + w2g * (r == 0 ? r0g : r1g);
            const f32x4 hcv = bv + w0v * (r == 0 ? a2v : a1v) + w1v * (r == 0 ? a1v : r0v) + w2v * (r == 0 ? r0v : r1v);
            const f32x2 ga = gelu_pk((f32x2){hcg[0], hcg[1]}), gb2 = gelu_pk((f32x2){hcg[2], hcg[3]});
            u32x2 w; w.x = cvt_pk_bf16(ga.x * hcv[0], ga.y * hcv[1]); w.y = cvt_pk_bf16(gb2.x * hcv[2], gb2.y * hcv[3]);
            *(u32x2*)(U + (size_t)(pm * 256 + r) * FF + cg) = w;
        }
    }
}

template <int NB, int UN>
__device__ __forceinline__ void small_mma(f32x4 (&acc)[NB], const bf16_t* ap, const bf16_t* const (&bp)[NB], int K) {
#pragma unroll 1
    for (int k0 = 0; k0 < K; k0 += 32 * UN) {
        bf16x8 a[UN], b[NB][UN];
#pragma unroll
        for (int u = 0; u < UN; ++u) { a[u] = *(const bf16x8*)(ap + k0 + 32 * u);
#pragma unroll
            for (int nb = 0; nb < NB; ++nb) b[nb][u] = *(const bf16x8*)(bp[nb] + k0 + 32 * u); }
#pragma unroll
        for (int u = 0; u < UN; ++u)
#pragma unroll
            for (int nb = 0; nb < NB; ++nb) acc[nb] = __builtin_amdgcn_mfma_f32_16x16x32_bf16(b[nb][u], a[u], acc[nb], 0, 0, 0);
    }
}
struct SmallId { int w, fr, fq, row; };
__device__ __forceinline__ SmallId small_id() { int tid = threadIdx.x; asm volatile("" : "+v"(tid)); SmallId i; i.w = __builtin_amdgcn_readfirstlane(tid >> 6); i.fr = tid & 15; i.fq = (tid & 63) >> 4; i.row = MP + 16 * i.w + i.fr; return i; }


template <int KSTEPS  >
__device__ __forceinline__ void small_mma_ksplit(f32x4 (&acc)[2], const bf16_t* A, int lda, const bf16_t* Bt, int ldb, int n0, LAS unsigned char* lds, const SmallId& id) {
    const int lane = id.fq * 16 + id.fr, k0 = id.w * (KSTEPS * 32);
    f32x4 part[8][2];
#pragma unroll
    for (int rb = 0; rb < 8; ++rb) { part[rb][0] = (f32x4){0.f, 0.f, 0.f, 0.f}; part[rb][1] = part[rb][0]; }
    const bf16_t* ap = A + (size_t)(MP + id.fr) * lda + k0 + 8 * id.fq;
    const bf16_t* bp = Bt + (size_t)(n0 + id.fr) * ldb + k0 + 8 * id.fq;
#pragma unroll 1
    for (int ks = 0; ks < KSTEPS; ++ks) {
        bf16x8 a[8], b[2];
#pragma unroll
        for (int rb = 0; rb < 8; ++rb) a[rb] = *(const bf16x8*)(ap + (size_t)(16 * rb) * lda + 32 * ks);
        b[0] = *(const bf16x8*)(bp + 32 * ks); b[1] = *(const bf16x8*)(bp + (size_t)16 * ldb + 32 * ks);
#pragma unroll
        for (int rb = 0; rb < 8; ++rb) { part[rb][0] = __builtin_amdgcn_mfma_f32_16x16x32_bf16(b[0], a[rb], part[rb][0], 0, 0, 0); part[rb][1] = __builtin_amdgcn_mfma_f32_16x16x32_bf16(b[1], a[rb], part[rb][1], 0, 0, 0); }
    }
    LAS f32x4* red = (LAS f32x4*)lds;
#pragma unroll
    for (int rb = 0; rb < 8; ++rb) { red[((id.w * 8 + rb) * 2 + 0) * 64 + lane] = part[rb][0]; red[((id.w * 8 + rb) * 2 + 1) * 64 + lane] = part[rb][1]; }
    asm volatile("s_waitcnt lgkmcnt(0)" ::: "memory"); __syncthreads();
    acc[0] = (f32x4){0.f, 0.f, 0.f, 0.f}; acc[1] = acc[0];
#pragma unroll
    for (int w2 = 0; w2 < 8; ++w2) { acc[0] += red[((w2 * 8 + id.w) * 2 + 0) * 64 + lane]; acc[1] += red[((w2 * 8 + id.w) * 2 + 1) * 64 + lane]; }
    asm volatile("s_waitcnt lgkmcnt(0)" ::: "memory"); __syncthreads();
}

__device__ __forceinline__ void small_proj(const Params& p, int l, int G, int bx) {
    const SmallId id = small_id();
    const bf16_t* XB = (const bf16_t*)(p.ws + WS_XB); const bf16_t* Bt = (const bf16_t*)(p.ws + WS_W + (size_t)l * W_LAYER + WO_IN); bf16_t* PROJ = (bf16_t*)(p.ws + WS_PROJ);
    const float* ssq = (const float*)(p.ws + WS_SSQ) + (2 * l) * MPAD; const float* gb = p.gate_bias + l * 2048;
    for (int ts = G - 1 - bx; ts < INW / 32; ts += G) {
        const int n0 = ts * 32; f32x4 acc[2] = {(f32x4){0.f, 0.f, 0.f, 0.f}, (f32x4){0.f, 0.f, 0.f, 0.f}};
        const bf16_t* ap = XB + (size_t)id.row * DM + 8 * id.fq;
        const bf16_t* const bp[2] = {Bt + (size_t)(n0 + id.fr) * DM + 8 * id.fq, Bt + (size_t)(n0 + 16 + id.fr) * DM + 8 * id.fq};
        small_mma<2, 8>(acc, ap, bp, DM);
        const float rs = __builtin_amdgcn_rsqf(ssq[id.row] * (1.0f / 1024.0f) + EPS);
#pragma unroll
        for (int nb = 0; nb < 2; ++nb) { const int col = n0 + 16 * nb + 4 * id.fq; float v[4];
#pragma unroll
            for (int j = 0; j < 4; ++j) { float x = acc[nb][j] * rs; if (n0 >= 1280) { x += gb[col - 1280 + j]; x = __builtin_amdgcn_rcpf(1.0f + __builtin_amdgcn_exp2f(-LOG2E * x)); } v[j] = x; }
            u32x2 w; w.x = cvt_pk_bf16(v[0], v[1]); w.y = cvt_pk_bf16(v[2], v[3]); *(u32x2*)(PROJ + (size_t)id.row * INW + col) = w; }
    }
}
__device__ __forceinline__ void small_mix(const Params& p, int l, LAS unsigned char* lds, int G, int bx) {
    const SmallId id = small_id();
    const bf16_t* AD = (const bf16_t*)(p.ws + WS_AD); const bf16_t* Bm = (const bf16_t*)(p.ws + WS_W + (size_t)l * W_LAYER + WO_MIX); const bf16_t* PROJ = (const bf16_t*)(p.ws + WS_PROJ); bf16_t* MIX = (bf16_t*)(p.ws + WS_MIX);
    for (int ts = G - 1 - bx; ts < DM / 32; ts += G) {
        const int n0 = ts * 32; f32x4 ya[2] = {(f32x4){0.f, 0.f, 0.f, 0.f}, (f32x4){0.f, 0.f, 0.f, 0.f}}, yb[2] = {(f32x4){0.f, 0.f, 0.f, 0.f}, (f32x4){0.f, 0.f, 0.f, 0.f}};
        small_mma_ksplit<2>(ya, AD, DM, Bm, 512, n0, lds, id);
        small_mma_ksplit<2>(yb, AD + 512, DM, Bm + (size_t)1024 * 512, 512, n0, lds, id);
#pragma unroll
        for (int nb = 0; nb < 2; ++nb) { const int col = n0 + 16 * nb + 4 * id.fq;
            const u32x2 g0 = *(const u32x2*)(PROJ + (size_t)id.row * INW + 1280 + col), g1 = *(const u32x2*)(PROJ + (size_t)id.row * INW + 2304 + col);
            const float v0 = bf_lo(g0.x) * ya[nb][0] + bf_lo(g1.x) * yb[nb][0], v1 = bf_hi(g0.x) * ya[nb][1] + bf_hi(g1.x) * yb[nb][1];
            const float v2 = bf_lo(g0.y) * ya[nb][2] + bf_lo(g1.y) * yb[nb][2], v3 = bf_hi(g0.y) * ya[nb][3] + bf_hi(g1.y) * yb[nb][3];
            u32x2 w; w.x = cvt_pk_bf16(v0, v1); w.y = cvt_pk_bf16(v2, v3); *(u32x2*)(MIX + (size_t)id.row * DM + col) = w; }
    }
}
template <bool RES_F32, bool OUT_F32, int KSTEPS>
__device__ __forceinline__ void small_res(const Params& p, LAS unsigned char* lds, const bf16_t* A, int lda, const bf16_t* Bt, int K, float* ssq_next, int G, int bx) {
    const SmallId id = small_id();
    bf16_t* XB = (bf16_t*)(p.ws + WS_XB);
    for (int ts = G - 1 - bx; ts < DM / 32; ts += G) {
        const int n0 = ts * 32; f32x4 acc[2] = {(f32x4){0.f, 0.f, 0.f, 0.f}, (f32x4){0.f, 0.f, 0.f, 0.f}};
        small_mma_ksplit<KSTEPS>(acc, A, lda, Bt, K, n0, lds, id);
        float s = 0.f;
#pragma unroll
        for (int nb = 0; nb < 2; ++nb) { const int col = n0 + 16 * nb + 4 * id.fq;
            f32x4 r;
            if (RES_F32) r = *(const f32x4*)(p.xs + (size_t)(id.row - MP) * DM + col);
            else { const u32x2 w = *(const u32x2*)(XB + (size_t)id.row * DM + col); r = (f32x4){bf_lo(w.x), bf_hi(w.x), bf_lo(w.y), bf_hi(w.y)}; }
            const f32x4 x = r + acc[nb];
            if (OUT_F32) *(f32x4*)(p.out + (size_t)id.row * DM + col) = x;
            else { u32x2 w; w.x = cvt_pk_bf16(x[0], x[1]); w.y = cvt_pk_bf16(x[2], x[3]); *(u32x2*)(XB + (size_t)id.row * DM + col) = w; }
            s += (x[0] * x[0] + x[1] * x[1]) + (x[2] * x[2] + x[3] * x[3]); }
        if (!OUT_F32) { s += __shfl_xor(s, 16); s += __shfl_xor(s, 32); if (id.fq == 0) atomicAdd(ssq_next + id.row, s); }
    }
}
__device__ __forceinline__ void small_up(const Params& p, int l, LAS unsigned char* lds, int G, int bx) {
    const SmallId id = small_id();
    const bf16_t* XB = (const bf16_t*)(p.ws + WS_XB); const bf16_t* Bu = (const bf16_t*)(p.ws + WS_W + (size_t)l * W_LAYER + WO_UP); bf16_t* U = (bf16_t*)(p.ws + WS_PROJ);
    const float* ssq = (const float*)(p.ws + WS_SSQ) + (2 * l + 1) * MPAD;
    const float* cw = p.conv_w + (size_t)l * 3 * FF2; const float* cb = p.conv_b + (size_t)l * FF2; const float* sconv = p.state_conv + (size_t)l * 8 * 2 * FF2; float* conv_s = p.out + O_CS + (size_t)l * 8 * 2 * FF2;
    for (int ts = G - 1 - bx; ts < FF / 32; ts += G) {
        const int c0 = ts * 32; f32x4 acc[4];
        const int rb0 = (c0 >> 7) * 256 + (c0 & 127);
        { f32x4 ag[2], av[2];
          small_mma_ksplit<4>(ag, XB, DM, Bu, DM, rb0, lds, id);
          small_mma_ksplit<4>(av, XB, DM, Bu, DM, rb0 + 128, lds, id);
          acc[0] = ag[0]; acc[1] = ag[1]; acc[2] = av[0]; acc[3] = av[1]; }
        const float rs = __builtin_amdgcn_rsqf(ssq[id.row] * (1.0f / 1024.0f) + EPS);
        const int fr = id.fr;
#pragma unroll
        for (int nb = 0; nb < 2; ++nb) {
            const int colg = c0 + 16 * nb + 4 * id.fq, colv = FF + colg;
            const f32x4 cg_ = acc[nb] * rs, cv_ = acc[2 + nb] * rs;
            f32x4 hg = (f32x4){0.f, 0.f, 0.f, 0.f}, hv = hg;
            if (fr >= 14) { const float* sp = sconv + (size_t)(id.w * 2 + (fr - 14)) * FF2; hg = *(const f32x4*)(sp + colg); hv = *(const f32x4*)(sp + colv); }
            const f32x4 w0g = *(const f32x4*)(cw + colg), w1g = *(const f32x4*)(cw + FF2 + colg), w2g = *(const f32x4*)(cw + 2 * FF2 + colg), bg = *(const f32x4*)(cb + colg);
            const f32x4 w0v = *(const f32x4*)(cw + colv), w1v = *(const f32x4*)(cw + FF2 + colv), w2v = *(const f32x4*)(cw + 2 * FF2 + colv), bv = *(const f32x4*)(cb + colv);
            f32x4 p1g, p2g, p1v, p2v;
#pragma unroll
            for (int j = 0; j < 4; ++j) {
                p1g[j] = ror1(fr == 15 ? hg[j] : cg_[j]); p2g[j] = ror2(fr >= 14 ? hg[j] : cg_[j]);
                p1v[j] = ror1(fr == 15 ? hv[j] : cv_[j]); p2v[j] = ror2(fr >= 14 ? hv[j] : cv_[j]);
            }
            const f32x4 hcg = bg + w0g * p2g + w1g * p1g + w2g * cg_;
            const f32x4 hcv = bv + w0v * p2v + w1v * p1v + w2v * cv_;
            const f32x2 ga = gelu_pk((f32x2){hcg[0], hcg[1]}), gb2 = gelu_pk((f32x2){hcg[2], hcg[3]});
            u32x2 w; w.x = cvt_pk_bf16(ga.x * hcv[0], ga.y * hcv[1]); w.y = cvt_pk_bf16(gb2.x * hcv[2], gb2.y * hcv[3]);
            *(u32x2*)(U + (size_t)id.row * FF + colg) = w;
            if (fr >= 14) { float* cp = conv_s + (size_t)(id.w * 2 + (fr - 14)) * FF2; *(f32x4*)(cp + colg) = cg_; *(f32x4*)(cp + colv) = cv_; }
        }
    }
}

__device__ __forceinline__ int crow(int r, int hi) { return (r & 3) + 8 * (r >> 2) + 4 * hi; }
constexpr int KS_LD = 72, VT_LD = 200, LDS_VT = 192 * KS_LD * 2, LDS_WSC = LDS_VT + 64 * VT_LD * 2, LDS_OST = LDS_WSC + 1024;


template <int W>
__device__ __forceinline__ void pool_items(const Params& p, int l, bool sample, int b, int c, int g, long row0, int tid) {
    const bf16_t* P = (const bf16_t*)(p.ws + WS_PROJ);
    bf16_t* AD = (bf16_t*)(p.ws + WS_AD);
    const int nitems = sample ? 16 * 16 : 64 * 16;
#pragma unroll 1
    for (int it = tid; it < nitems; it += 512) {
        const int tl = it >> 4, ch = it & 15, col = g * 128 + ch * 8;
        const long prow = row0 + tl; const int t = sample ? tl : c * 64 + tl;
        u32x4 raw[W]; f32x4 h0[W], h1[W];
#pragma unroll
        for (int i = 0; i < W; ++i) {
            const int tt = t - i;
            raw[i] = (u32x4){0u, 0u, 0u, 0u}; h0[i] = (f32x4){0.f, 0.f, 0.f, 0.f}; h1[i] = h0[i];
            if (tt >= 0) raw[i] = *(const u32x4*)(P + (size_t)(prow - i) * INW + 768 + col);
            else if (sample) { const float* sp = p.state_pool + (((size_t)l * 8 + b) * 15 + (15 + tt)) * 512 + col; h0[i] = *(const f32x4*)sp; h1[i] = *(const f32x4*)(sp + 4); }
        }
        float cur[8], a[8];
        unpack8(raw[0], cur);
#pragma unroll
        for (int k = 0; k < 8; ++k) a[k] = cur[k];
#pragma unroll
        for (int i = 1; i < W; ++i) { float x[8]; unpack8(raw[i], x);
#pragma unroll
            for (int k = 0; k < 4; ++k) { a[k] += x[k] + h0[i][k]; a[4 + k] += x[4 + k] + h1[i][k]; } }
        const float cnt = sample ? (float)W : (float)((t + 1) < W ? (t + 1) : W);
        const float inv = 1.0f / cnt;
        float d[8];
#pragma unroll
        for (int k = 0; k < 8; ++k) d[k] = a[k] * inv - cur[k];
        *(u32x4*)(AD + (size_t)prow * DM + 512 + col) = pack8(d);
        float* pd = nullptr;
        if (!sample) { if (t >= SEQ - 15) pd = p.out + O_PP + (((size_t)l * 2 + b) * 15 + (t - (SEQ - 15))) * 512 + col; }
        else if (tl >= 1) pd = p.out + O_PS + (((size_t)l * 8 + b) * 15 + (tl - 1)) * 512 + col;
        if (pd) { *(f32x4*)pd = (f32x4){cur[0], cur[1], cur[2], cur[3]}; *(f32x4*)(pd + 4) = (f32x4){cur[4], cur[5], cur[6], cur[7]}; }
    }
}

template <int W>
__device__ __forceinline__ void pool_task_prompt(const Params& p, int l, int b, int c, int g, int rg, int ch, long row0) {
    const bf16_t* P = (const bf16_t*)(p.ws + WS_PROJ);
    bf16_t* AD = (bf16_t*)(p.ws + WS_AD);
    const int col = g * 128 + ch * 8, tl0 = 4 * rg, t0 = c * 64 + tl0;
    u32x4 raw[W + 3];
#pragma unroll
    for (int i = 0; i < W + 3; ++i) { const int tt = t0 - (W - 1) + i; raw[i] = (u32x4){0u, 0u, 0u, 0u};
        if (tt >= 0) raw[i] = *(const u32x4*)(P + (size_t)((long)b * SEQ + tt) * INW + 768 + col); }
    float a[4][8], cur[4][8];
#pragma unroll
    for (int k = 0; k < 8; ++k) a[0][k] = 0.f;
#pragma unroll
    for (int i = 0; i < W; ++i) { float x[8]; unpack8(raw[i], x);
#pragma unroll
        for (int k = 0; k < 8; ++k) { a[0][k] += x[k]; if (i == W - 1) cur[0][k] = x[k]; } }
#pragma unroll
    for (int r = 1; r < 4; ++r) { float xin[8], xout[8]; unpack8(raw[W - 1 + r], xin); unpack8(raw[r - 1], xout);
#pragma unroll
        for (int k = 0; k < 8; ++k) { a[r][k] = a[r - 1][k] + (xin[k] - xout[k]); cur[r][k] = xin[k]; } }
#pragma unroll
    for (int r = 0; r < 4; ++r) {
        const int t = t0 + r;
        const float inv = 1.0f / (float)((t + 1) < W ? (t + 1) : W);
        float d[8];
#pragma unroll
        for (int k = 0; k < 8; ++k) d[k] = a[r][k] * inv - cur[r][k];
        *(u32x4*)(AD + (size_t)(row0 + tl0 + r) * DM + 512 + col) = pack8(d);
        if (t >= SEQ - 15) { float* pd = p.out + O_PP + (((size_t)l * 2 + b) * 15 + (t - (SEQ - 15))) * 512 + col;
            *(f32x4*)pd = (f32x4){cur[r][0], cur[r][1], cur[r][2], cur[r][3]}; *(f32x4*)(pd + 4) = (f32x4){cur[r][4], cur[r][5], cur[r][6], cur[r][7]}; }
    }
}

__device__ __forceinline__ void attn_unit(const Params& p, int l, LAS unsigned char* lds, bool sample, int b, int c, int kvh) {
    int tid = threadIdx.x; asm volatile("" : "+v"(tid));
    const int wid = __builtin_amdgcn_readfirstlane(tid >> 6);
    int lane = tid & 63; asm volatile("" : "+v"(lane));
    const int q32 = lane & 31, hi = lane >> 5;
    LAS bf16_t* Ks = (LAS bf16_t*)lds; LAS bf16_t* Vt = (LAS bf16_t*)(lds + LDS_VT); LAS float* wsc = (LAS float*)(lds + LDS_WSC) + wid * 32;
    const bf16_t* P = (const bf16_t*)(p.ws + WS_PROJ);
    bf16_t* AD = (bf16_t*)(p.ws + WS_AD);
    const long row0 = sample ? (long)MP + b * 16 : (long)b * SEQ + c * 64;
    if (sample) {
#pragma unroll
        for (int gl = 0; gl < 2; ++gl) {
            const int g = kvh * 2 + gl;
            if (g == 0) pool_items<2>(p, l, sample, b, c, g, row0, tid);
            else if (g == 1) pool_items<4>(p, l, sample, b, c, g, row0, tid);
            else if (g == 2) pool_items<8>(p, l, sample, b, c, g, row0, tid);
            else pool_items<16>(p, l, sample, b, c, g, row0, tid);
        }
        __builtin_amdgcn_sched_barrier(0);
    }
    const int gq = wid >> 1, half = wid & 1, h = kvh * 4 + gq;
    const bool active = !sample || half == 0;
    const int tq = half * 32 + q32;
    const long qrow = sample ? row0 + (q32 & 15) : row0 + tq;
    u32x4 qraw[4];
#pragma unroll
    for (int d0 = 0; d0 < 4; ++d0) qraw[d0] = *(const u32x4*)(P + (size_t)qrow * INW + h * 64 + d0 * 16 + hi * 8);
    u32x4 kraw[3], vraw[3]; f32x4 kc0[3], kc1[3], vc0[3], vc1[3];
#pragma unroll
    for (int it = 0; it < 3; ++it) {
        const int idx = it * 512 + tid, j = idx >> 3, ch = idx & 7;
        kraw[it] = (u32x4){0u, 0u, 0u, 0u}; vraw[it] = kraw[it];
        kc0[it] = (f32x4){0.f, 0.f, 0.f, 0.f}; kc1[it] = kc0[it]; vc0[it] = kc0[it]; vc1[it] = kc0[it];
        if (!sample) { const int tk = c * 64 - 128 + j;
            if (tk >= 0) { const size_t o = (size_t)((long)b * SEQ + tk) * INW + kvh * 64 + ch * 8; kraw[it] = *(const u32x4*)(P + o + 512); vraw[it] = *(const u32x4*)(P + o + 640); } }
        else if (j < 128) { const size_t ci = ((((size_t)l * 8 + b) * 128 + j) * 2 + kvh) * 64 + ch * 8;
            kc0[it] = *(const f32x4*)(p.cache_k + ci); kc1[it] = *(const f32x4*)(p.cache_k + ci + 4); vc0[it] = *(const f32x4*)(p.cache_v + ci); vc1[it] = *(const f32x4*)(p.cache_v + ci + 4); }
        else if (j < 144) { const size_t o = (size_t)((long)MP + b * 16 + (j - 128)) * INW + kvh * 64 + ch * 8; kraw[it] = *(const u32x4*)(P + o + 512); vraw[it] = *(const u32x4*)(P + o + 640); }
    }
    if (!sample) {
        const int gl = tid >> 8, g = kvh * 2 + gl, rg = (tid >> 4) & 15, ch = tid & 15;
        if (g == 0) pool_task_prompt<2>(p, l, b, c, g, rg, ch, row0);
        else if (g == 1) pool_task_prompt<4>(p, l, b, c, g, rg, ch, row0);
        else if (g == 2) pool_task_prompt<8>(p, l, b, c, g, rg, ch, row0);
        else pool_task_prompt<16>(p, l, b, c, g, rg, ch, row0);
    }
    const float* knorm = p.k_norm + l * 64;
#pragma unroll
    for (int it = 0; it < 3; ++it) {
        const int idx = it * 512 + tid, j = idx >> 3, ch = idx & 7;
        float kf[8], vf[8];
        const bool fromproj = !sample || j >= 128;
        if (fromproj) { unpack8(kraw[it], kf); unpack8(vraw[it], vf); }
        else {
#pragma unroll
            for (int i = 0; i < 4; ++i) { kf[i] = kc0[it][i]; kf[4 + i] = kc1[it][i]; vf[i] = vc0[it][i]; vf[4 + i] = vc1[it][i]; } }
        float ss = 0.f;
#pragma unroll
        for (int i = 0; i < 8; ++i) ss += kf[i] * kf[i];
        ss += __shfl_xor(ss, 1); ss += __shfl_xor(ss, 2); ss += __shfl_xor(ss, 4);
        if (fromproj) { const float sc = __builtin_amdgcn_rsqf(ss * (1.0f / 64.0f) + EPS);
#pragma unroll
            for (int i = 0; i < 8; ++i) kf[i] = kf[i] * sc * knorm[ch * 8 + i]; }
        *(LAS u32x4*)(Ks + j * KS_LD + ch * 8) = pack8(kf);
#pragma unroll
        for (int i = 0; i < 8; i += 2) { const unsigned w = cvt_pk_bf16(vf[i], vf[i + 1]); const int js = j ^ (ch << 3);
            Vt[(ch * 8 + i) * VT_LD + js] = (bf16_t)(w & 0xffffu); Vt[(ch * 8 + i + 1) * VT_LD + js] = (bf16_t)(w >> 16); }
        float* kd = nullptr; float* vd = nullptr;
        if (!sample) { if (c >= 254 && j >= 128) { const size_t o = ((((size_t)l * 2 + b) * 128 + (c - 254) * 64 + (j - 128)) * 2 + kvh) * 64 + ch * 8; kd = p.out + O_KP + o; vd = p.out + O_VP + o; } }
        else if (j >= 16 && j < 144) { const size_t o = ((((size_t)l * 8 + b) * 128 + (j - 16)) * 2 + kvh) * 64 + ch * 8; kd = p.out + O_KS + o; vd = p.out + O_VS + o; }
        if (kd) { *(f32x4*)kd = (f32x4){kf[0], kf[1], kf[2], kf[3]}; *(f32x4*)(kd + 4) = (f32x4){kf[4], kf[5], kf[6], kf[7]};
                  *(f32x4*)vd = (f32x4){vf[0], vf[1], vf[2], vf[3]}; *(f32x4*)(vd + 4) = (f32x4){vf[4], vf[5], vf[6], vf[7]}; }
    }
    bf16x8 qf[4];
    {
        float qv[4][8]; float ss = 0.f;
#pragma unroll
        for (int d0 = 0; d0 < 4; ++d0) { unpack8(qraw[d0], qv[d0]);
#pragma unroll
            for (int i = 0; i < 8; ++i) ss += qv[d0][i] * qv[d0][i]; }
        ss += __shfl_xor(ss, 32);
        const float sc = __builtin_amdgcn_rsqf(ss * (1.0f / 64.0f) + EPS) * (0.125f * LOG2E);
        const float* qn = p.q_norm + l * 64;
#pragma unroll
        for (int d0 = 0; d0 < 4; ++d0) { float t8[8];
#pragma unroll
            for (int i = 0; i < 8; ++i) t8[i] = qv[d0][i] * sc * qn[d0 * 16 + hi * 8 + i];
            qf[d0] = __builtin_bit_cast(bf16x8, pack8(t8)); }
    }
    __syncthreads();
    if (active) {
        f32x16 s[6];
#pragma unroll
        for (int kt = 0; kt < 6; ++kt) {
            s[kt] = (f32x16){};
#pragma unroll
            for (int d0 = 0; d0 < 4; ++d0) {
                const bf16x8 kfr = *(const LAS bf16x8*)(Ks + (kt * 32 + q32) * KS_LD + d0 * 16 + hi * 8);
                s[kt] = __builtin_amdgcn_mfma_f32_32x32x16_bf16(kfr, qf[d0], s[kt], 0, 0, 0);
            }
        }
        const float slope2 = __builtin_amdgcn_exp2f(-(float)(h + 1)) * LOG2E;
        const int jmin = sample ? 0 : (c >= 2 ? 0 : 128 - 64 * c), jmax = sample ? 144 : 192;
        float mx = -3.0e38f;
        const float relb = (float)(128 + tq - 4 * hi);
        const bool need_mask = sample || c < 2;
#pragma unroll
        for (int kt = 0; kt < 6; ++kt)
#pragma unroll
            for (int r = 0; r < 16; ++r) {
                float v = __builtin_fmaf(-slope2, __builtin_fabsf(relb - (float)(32 * kt + (r & 3) + 8 * (r >> 2))), s[kt][r]);
                if (need_mask) { const int j = 32 * kt + crow(r, hi); if (j < jmin || j >= jmax) v = -1.0e30f; }
                s[kt][r] = v; mx = __builtin_fmaxf(mx, v);
            }
        mx = __builtin_fmaxf(mx, __shfl_xor(mx, 32));
        const float sink2 = p.sinks[l * 8 + h] * LOG2E;
        const float mm = __builtin_fmaxf(mx, sink2);
        float sum = 0.f;
#pragma unroll
        for (int kt = 0; kt < 6; ++kt)
#pragma unroll
            for (int r = 0; r < 16; ++r) { const float e = __builtin_amdgcn_exp2f(s[kt][r] - mm); s[kt][r] = e; sum += e; }
        sum += __shfl_xor(sum, 32);
        const float denom = sum + __builtin_amdgcn_exp2f(sink2 - mm);
        if (hi == 0) wsc[q32] = 1.0f / denom;
        f32x16 o[2]; o[0] = (f32x16){}; o[1] = (f32x16){};
#pragma unroll
        for (int kt = 0; kt < 6; ++kt)
#pragma unroll
            for (int jj = 0; jj < 2; ++jj) {
                u32x4 pw;
                pw.x = cvt_pk_bf16(s[kt][8 * jj + 0], s[kt][8 * jj + 1]); pw.y = cvt_pk_bf16(s[kt][8 * jj + 2], s[kt][8 * jj + 3]);
                pw.z = cvt_pk_bf16(s[kt][8 * jj + 4], s[kt][8 * jj + 5]); pw.w = cvt_pk_bf16(s[kt][8 * jj + 6], s[kt][8 * jj + 7]);
                const bf16x8 pa = __builtin_bit_cast(bf16x8, pw);
                const int e0 = 32 * kt + 16 * jj + 4 * hi;
#pragma unroll
                for (int db = 0; db < 2; ++db) {
                    const int sw = (((db * 32 + q32) >> 3) & 7) << 3;
                    const u32x2 lo = *(const LAS u32x2*)(Vt + (db * 32 + q32) * VT_LD + (e0 ^ sw)), hi2 = *(const LAS u32x2*)(Vt + (db * 32 + q32) * VT_LD + ((e0 + 8) ^ sw));
                    const bf16x8 vb = __builtin_bit_cast(bf16x8, (u32x4){lo.x, lo.y, hi2.x, hi2.y});
                    o[db] = __builtin_amdgcn_mfma_f32_32x32x16_bf16(pa, vb, o[db], 0, 0, 0);
                }
                __builtin_amdgcn_sched_barrier(0);
            }
        asm volatile("s_waitcnt lgkmcnt(0)" ::: "memory");
        LAS bf16_t* ost = (LAS bf16_t*)(lds + LDS_OST) + wid * (32 * 72);
#pragma unroll
        for (int r = 0; r < 16; ++r) {
            const int qq = crow(r, hi);
            const float inv = wsc[qq];
#pragma unroll
            for (int db = 0; db < 2; ++db) ost[qq * 72 + db * 32 + q32] = (bf16_t)(cvt_pk_bf16(o[db][r] * inv, 0.f) & 0xffffu);
        }
        asm volatile("s_waitcnt lgkmcnt(0)" ::: "memory");
#pragma unroll
        for (int i = 0; i < 4; ++i) {
            const int row = i * 8 + (lane >> 3), chn = lane & 7;
            const u32x4 v = *(const LAS u32x4*)(ost + row * 72 + chn * 8);
            if (!sample || row < 16) { const long orow = sample ? row0 + row : row0 + half * 32 + row; *(u32x4*)(AD + (size_t)orow * DM + h * 64 + chn * 8) = v; }
        }
    }
    __syncthreads();
}


constexpr int MK_LD = 72, MV_LD = 392, M_VT = 384 * MK_LD * 2, M_WSC = M_VT + 64 * MV_LD * 2, M_OST = M_WSC + 1024;
static_assert(M_OST + 8 * 32 * 72 * 2 <= MISC_OFF, "attention macro-unit LDS map");
__device__ __forceinline__ void attn_macro(const Params& p, int l, LAS unsigned char* lds, int b, int cg, int kvh) {
    int tid = threadIdx.x; asm volatile("" : "+v"(tid));
    const int wid = __builtin_amdgcn_readfirstlane(tid >> 6);
    int lane = tid & 63; asm volatile("" : "+v"(lane));
    const int q32 = lane & 31, hi = lane >> 5;
    LAS bf16_t* Ks = (LAS bf16_t*)lds; LAS bf16_t* Vt = (LAS bf16_t*)(lds + M_VT); LAS float* wsc = (LAS float*)(lds + M_WSC) + wid * 32;
    const bf16_t* P = (const bf16_t*)(p.ws + WS_PROJ);
    bf16_t* AD = (bf16_t*)(p.ws + WS_AD);
    const int c0 = 4 * cg;
    const long rowb = (long)b * SEQ;
    const int gq = wid >> 1, half = wid & 1, h = kvh * 4 + gq, tq = half * 32 + q32;
    u32x4 qraw[4];
#pragma unroll
    for (int i = 0; i < 4; ++i) qraw[i] = *(const u32x4*)(P + (size_t)(rowb + c0 * 64 + half * 32 + i * 8 + (lane >> 3)) * INW + h * 64 + (lane & 7) * 8);
    u32x4 kraw[6], vraw[6];
#pragma unroll
    for (int it = 0; it < 6; ++it) {
        const int idx = it * 512 + tid, j = idx >> 3, ch = idx & 7, tk = c0 * 64 - 128 + j;
        kraw[it] = (u32x4){0u, 0u, 0u, 0u}; vraw[it] = kraw[it];
        if (tk >= 0) { const size_t o = (size_t)(rowb + tk) * INW + kvh * 64 + ch * 8; kraw[it] = *(const u32x4*)(P + o + 512); vraw[it] = *(const u32x4*)(P + o + 640); }
    }
    const float* knorm = p.k_norm + l * 64;
#pragma unroll
    for (int it = 0; it < 6; ++it) {
        const int idx = it * 512 + tid, j = idx >> 3, ch = idx & 7;
        float kf[8], vf[8]; unpack8(kraw[it], kf); unpack8(vraw[it], vf);
        float ss = 0.f;
#pragma unroll
        for (int i = 0; i < 8; ++i) ss += kf[i] * kf[i];
        ss += __shfl_xor(ss, 1); ss += __shfl_xor(ss, 2); ss += __shfl_xor(ss, 4);
        const float sc = __builtin_amdgcn_rsqf(ss * (1.0f / 64.0f) + EPS);
#pragma unroll
        for (int i = 0; i < 8; ++i) kf[i] = kf[i] * sc * knorm[ch * 8 + i];
        *(LAS u32x4*)(Ks + j * MK_LD + ch * 8) = pack8(kf);
        const int js = j ^ (ch << 3);
#pragma unroll
        for (int i = 0; i < 8; i += 2) { const unsigned w = cvt_pk_bf16(vf[i], vf[i + 1]); Vt[(ch * 8 + i) * MV_LD + js] = (bf16_t)(w & 0xffffu); Vt[(ch * 8 + i + 1) * MV_LD + js] = (bf16_t)(w >> 16); }
        if (cg == 63 && j >= 256) {
            const size_t o = ((((size_t)l * 2 + b) * 128 + (j - 256)) * 2 + kvh) * 64 + ch * 8; float* kd = p.out + O_KP + o; float* vd = p.out + O_VP + o;
            *(f32x4*)kd = (f32x4){kf[0], kf[1], kf[2], kf[3]}; *(f32x4*)(kd + 4) = (f32x4){kf[4], kf[5], kf[6], kf[7]};
            *(f32x4*)vd = (f32x4){vf[0], vf[1], vf[2], vf[3]}; *(f32x4*)(vd + 4) = (f32x4){vf[4], vf[5], vf[6], vf[7]};
        }
    }
    __syncthreads();
    const float slope2 = __builtin_amdgcn_exp2f(-(float)(h + 1)) * LOG2E;
    const float sink2 = p.sinks[l * 8 + h] * LOG2E;
    const float* qn = p.q_norm + l * 64;
#pragma unroll 1
    for (int ci = 0; ci < 4; ++ci) {
        const int c = c0 + ci;
        const long row0 = rowb + (long)c * 64;
        int lane_ = lane; asm volatile("" : "+v"(lane_));
        const int q32 = lane_ & 31, hi = lane_ >> 5, tq = half * 32 + q32;
        const float relb = (float)(128 + tq - 4 * hi);
        bf16x8 qf[4];
        {
            LAS bf16_t* qst = (LAS bf16_t*)(lds + M_OST) + wid * (32 * 72);
#pragma unroll
            for (int i = 0; i < 4; ++i) *(LAS u32x4*)(qst + (i * 8 + (lane_ >> 3)) * 72 + (lane_ & 7) * 8) = qraw[i];
            asm volatile("s_waitcnt lgkmcnt(0)" ::: "memory");
            float qv[4][8]; float ss = 0.f;
#pragma unroll
            for (int d0 = 0; d0 < 4; ++d0) { unpack8(*(const LAS u32x4*)(qst + q32 * 72 + d0 * 16 + hi * 8), qv[d0]);
#pragma unroll
                for (int i = 0; i < 8; ++i) ss += qv[d0][i] * qv[d0][i]; }
            asm volatile("s_waitcnt lgkmcnt(0)" ::: "memory");
            ss += __shfl_xor(ss, 32);
            const float sc = __builtin_amdgcn_rsqf(ss * (1.0f / 64.0f) + EPS) * (0.125f * LOG2E);
#pragma unroll
            for (int d0 = 0; d0 < 4; ++d0) { float t8[8];
#pragma unroll
                for (int i = 0; i < 8; ++i) t8[i] = qv[d0][i] * sc * qn[d0 * 16 + hi * 8 + i];
                qf[d0] = __builtin_bit_cast(bf16x8, pack8(t8)); }
        }
        if (ci < 3) {
#pragma unroll
            for (int i = 0; i < 4; ++i) qraw[i] = *(const u32x4*)(P + (size_t)(row0 + 64 + half * 32 + i * 8 + (lane_ >> 3)) * INW + h * 64 + (lane_ & 7) * 8);
        }
        f32x16 s[6];
#pragma unroll
        for (int kt = 0; kt < 6; ++kt) {
            s[kt] = (f32x16){};
#pragma unroll
            for (int d0 = 0; d0 < 4; ++d0) {
                const bf16x8 kfr = *(const LAS bf16x8*)(Ks + (ci * 64 + kt * 32 + q32) * MK_LD + d0 * 16 + hi * 8);
                s[kt] = __builtin_amdgcn_mfma_f32_32x32x16_bf16(kfr, qf[d0], s[kt], 0, 0, 0);
            }
        }
        const int jmin = c >= 2 ? 0 : 128 - 64 * c;
        float mx = -3.0e38f;
#pragma unroll
        for (int kt = 0; kt < 6; ++kt)
#pragma unroll
            for (int r = 0; r < 16; ++r) {
                float v = __builtin_fmaf(-slope2, __builtin_fabsf(relb - (float)(32 * kt + (r & 3) + 8 * (r >> 2))), s[kt][r]);
                if (c < 2) { const int j = 32 * kt + crow(r, hi); if (j < jmin) v = -1.0e30f; }
                s[kt][r] = v; mx = __builtin_fmaxf(mx, v);
            }
        mx = __builtin_fmaxf(mx, __shfl_xor(mx, 32));
        const float mm = __builtin_fmaxf(mx, sink2);
        float sum = 0.f;
#pragma unroll
        for (int kt = 0; kt < 6; ++kt)
#pragma unroll
            for (int r = 0; r < 16; ++r) { const float e = __builtin_amdgcn_exp2f(s[kt][r] - mm); s[kt][r] = e; sum += e; }
        sum += __shfl_xor(sum, 32);
        const float denom = sum + __builtin_amdgcn_exp2f(sink2 - mm);
        if (hi == 0) wsc[q32] = 1.0f / denom;
        f32x16 o[2]; o[0] = (f32x16){}; o[1] = (f32x16){};
#pragma unroll
        for (int kt = 0; kt < 6; ++kt)
#pragma unroll
            for (int jj = 0; jj < 2; ++jj) {
                u32x4 pw;
                pw.x = cvt_pk_bf16(s[kt][8 * jj + 0], s[kt][8 * jj + 1]); pw.y = cvt_pk_bf16(s[kt][8 * jj + 2], s[kt][8 * jj + 3]);
                pw.z = cvt_pk_bf16(s[kt][8 * jj + 4], s[kt][8 * jj + 5]); pw.w = cvt_pk_bf16(s[kt][8 * jj + 6], s[kt][8 * jj + 7]);
                const bf16x8 pa = __builtin_bit_cast(bf16x8, pw);
                const int e0 = 32 * kt + 16 * jj + 4 * hi;
#pragma unroll
                for (int db = 0; db < 2; ++db) {
                    const int sw = (((db * 32 + q32) >> 3) & 7) << 3;
                    const LAS bf16_t* vrow = Vt + (db * 32 + q32) * MV_LD + ci * 64;
                    const u32x2 lo = *(const LAS u32x2*)(vrow + (e0 ^ sw)), hi2 = *(const LAS u32x2*)(vrow + ((e0 + 8) ^ sw));
                    const bf16x8 vb = __builtin_bit_cast(bf16x8, (u32x4){lo.x, lo.y, hi2.x, hi2.y});
                    o[db] = __builtin_amdgcn_mfma_f32_32x32x16_bf16(pa, vb, o[db], 0, 0, 0);
                }
                __builtin_amdgcn_sched_barrier(0);
            }
        asm volatile("s_waitcnt lgkmcnt(0)" ::: "memory");
        LAS bf16_t* ost = (LAS bf16_t*)(lds + M_OST) + wid * (32 * 72);
#pragma unroll
        for (int r = 0; r < 16; ++r) {
            const int qq = crow(r, hi);
            const float inv = wsc[qq];
#pragma unroll
            for (int db = 0; db < 2; ++db) ost[qq * 72 + db * 32 + q32] = (bf16_t)(cvt_pk_bf16(o[db][r] * inv, 0.f) & 0xffffu);
        }
        asm volatile("s_waitcnt lgkmcnt(0)" ::: "memory");
#pragma unroll
        for (int i = 0; i < 4; ++i) {
            const int row = i * 8 + (lane >> 3), chn = lane & 7;
            const u32x4 v = *(const LAS u32x4*)(ost + row * 72 + chn * 8);
            *(u32x4*)(AD + (size_t)(row0 + half * 32 + row) * DM + h * 64 + chn * 8) = v;
        }
        asm volatile("s_waitcnt lgkmcnt(0)" ::: "memory");
    }
    {
        const int gl = tid >> 8, g = kvh * 2 + gl, rg = (tid >> 4) & 15, ch = tid & 15;
#pragma unroll 1
        for (int ci = 0; ci < 4; ++ci) {
            const int c = c0 + ci; const long row0 = rowb + (long)c * 64;
            if (g == 0) pool_task_prompt<2>(p, l, b, c, g, rg, ch, row0);
            else if (g == 1) pool_task_prompt<4>(p, l, b, c, g, rg, ch, row0);
            else if (g == 2) pool_task_prompt<8>(p, l, b, c, g, rg, ch, row0);
            else pool_task_prompt<16>(p, l, b, c, g, rg, ch, row0);
        }
    }
    __syncthreads();
}

__device__ __forceinline__ float wave_sum(float v) {
#pragma unroll
    for (int o = 1; o < 64; o <<= 1) v += __shfl_xor(v, o);
    return v;
}
__device__ __forceinline__ void transpose_item(const float* W, int N, const float* ks, bf16_t* WT, int ldo, int orow0, int k0, int n0, LAS float* scr, int lane) {
    f32x4 v[8];
#pragma unroll
    for (int i = 0; i < 8; ++i) v[i] = *(const f32x4*)(W + (size_t)(k0 + i * 4 + (lane >> 4)) * N + n0 + 4 * (lane & 15));
#pragma unroll
    for (int i = 0; i < 8; ++i) { const int kk = i * 4 + (lane >> 4); const float sc = ks ? ks[k0 + kk] : 1.0f; LAS float* d = scr + kk * 65 + 4 * (lane & 15);
        d[0] = v[i][0] * sc; d[1] = v[i][1] * sc; d[2] = v[i][2] * sc; d[3] = v[i][3] * sc; }
    asm volatile("s_waitcnt lgkmcnt(0)" ::: "memory");
    const int kc = lane & 3;
#pragma unroll
    for (int j = 0; j < 4; ++j) { const int n = (lane >> 2) + 16 * j; const LAS float* s = scr + (8 * kc) * 65 + n;
        u32x4 o; o.x = cvt_pk_bf16(s[0 * 65], s[1 * 65]); o.y = cvt_pk_bf16(s[2 * 65], s[3 * 65]); o.z = cvt_pk_bf16(s[4 * 65], s[5 * 65]); o.w = cvt_pk_bf16(s[6 * 65], s[7 * 65]);
        *(u32x4*)(WT + (size_t)(orow0 + n) * ldo + k0 + 8 * kc) = o; }
    asm volatile("s_waitcnt lgkmcnt(0)" ::: "memory");
}

constexpr int WI_IN = 32 * 52, WI_BA = 16 * 16, WI_OUT = 32 * 16, WI_UP = 32 * 88, WI_DN = 88 * 16, WI_L = WI_IN + WI_BA + WI_OUT + WI_UP + WI_DN;
__device__ __forceinline__ void convert_weights(const Params& p, LAS unsigned char* lds, int first, int last, int worker, int nworkers) {
    int tid = threadIdx.x; asm volatile("" : "+v"(tid));
    const int lane = tid & 63, wid = __builtin_amdgcn_readfirstlane(tid >> 6);
    LAS float* scr = (LAS float*)(lds + wid * 16384);
#pragma unroll 1
    for (int it = first + worker; it < last; it += nworkers) {
        const int l = it / WI_L; int r = it % WI_L;
        unsigned char* wb = p.ws + WS_W + (size_t)l * W_LAYER;
        if (r < WI_IN) { const int kb = r / 52, nb = r % 52; transpose_item(p.w_in + (size_t)l * DM * INW, INW, p.norm_mix + l * DM, (bf16_t*)(wb + WO_IN), DM, nb * 64, kb * 32, nb * 64, scr, lane); continue; } r -= WI_IN;
        if (r < WI_BA) { const int kb = r / 16, nb = r % 16; transpose_item(p.w_br_attn + (size_t)l * 512 * DM, DM, nullptr, (bf16_t*)(wb + WO_MIX), 512, nb * 64, kb * 32, nb * 64, scr, lane); continue; } r -= WI_BA;
        if (r < WI_OUT) { const int kb = r / 16, nb = r % 16; transpose_item(p.w_out + (size_t)l * DM * DM, DM, nullptr, (bf16_t*)(wb + WO_OUT), DM, nb * 64, kb * 32, nb * 64, scr, lane); continue; } r -= WI_OUT;
        if (r < WI_UP) { const int kb = r / 88, nb = r % 88; const int n0 = nb * 64; const int nn = n0 < FF ? n0 : n0 - FF; const int orow = (nn >> 7) * 256 + (n0 < FF ? 0 : 128) + (nn & 127);
            transpose_item(p.w_up + (size_t)l * DM * FF2, FF2, p.norm_ffn + l * DM, (bf16_t*)(wb + WO_UP), DM, orow, kb * 32, n0, scr, lane); continue; } r -= WI_UP;
        { const int kb = r / 16, nb = r % 16; transpose_item(p.w_down + (size_t)l * FF * DM, DM, nullptr, (bf16_t*)(wb + WO_DOWN), FF, nb * 64, kb * 32, nb * 64, scr, lane); }
    }
}
__device__ __forceinline__ void convert_weights_idle(const Params& p, LAS unsigned char* lds, int first, int last, int nwg, int G, int bx) {
    int tid = threadIdx.x; asm volatile("" : "+v"(tid));
    const int rem = nwg % G, wid = __builtin_amdgcn_readfirstlane(tid >> 6);
    if (bx >= rem) convert_weights(p, lds, first, last, (bx - rem) * 8 + wid, (G - rem) * 8);
}
__device__ __forceinline__ void prologue(const Params& p, LAS unsigned char* lds) {
    const int tid = threadIdx.x, lane = tid & 63, wid = __builtin_amdgcn_readfirstlane(tid >> 6);
    const int gt = blockIdx.x * 512 + tid, NGT = gridDim.x * 512;
    float* ssq = (float*)(p.ws + WS_SSQ);
    for (int i = gt; i < 3 * MPAD; i += NGT) ssq[MPAD + i] = 0.f;
    {
        const int gwv = blockIdx.x * 8 + wid, NGWV = gridDim.x * 8;
        for (int it = gwv; it < 2 * 1024; it += NGWV) {
            const int l = it >> 10, r = it & 1023, nblk = r & 15, kg = r >> 4, g = kg >> 4, c0 = (kg & 15) * 8, n = nblk * 64 + lane;
            const float* wp = p.w_pool + ((size_t)l * 4 + g) * 128 * 128 + (size_t)c0 * 128;
            const float* sc = p.pool_scale + l * 512 + g * 128;
            const float* wb = p.w_br_pool + (size_t)l * 512 * DM + (size_t)(g * 128) * DM + n;
            float a[8];
#pragma unroll
            for (int i = 0; i < 8; ++i) a[i] = 0.f;
#pragma unroll 8
            for (int d = 0; d < 128; ++d) { const float x = wb[(size_t)d * DM] * sc[d];
#pragma unroll
                for (int i = 0; i < 8; ++i) a[i] += wp[i * 128 + d] * x; }
            bf16_t* dst = (bf16_t*)(p.ws + WS_W + (size_t)l * W_LAYER + WO_MIX) + (size_t)(1024 + n) * 512 + g * 128 + c0;
            *(u32x4*)dst = pack8(a);
        }
    }
    convert_weights(p, lds, 0, WI_IN, blockIdx.x * 8 + wid, gridDim.x * 8);
    {
        bf16_t* XB = (bf16_t*)(p.ws + WS_XB);
        const int gw = blockIdx.x * 8 + wid, NGW = gridDim.x * 8;
#pragma unroll 1
        for (int m0 = gw; m0 < MREAL; m0 += 4 * NGW) {
            f32x4 v[4][4];
#pragma unroll
            for (int r = 0; r < 4; ++r) { const int m = m0 + r * NGW;
                if (m < MREAL) { const f32x4* xr = (const f32x4*)(m < MP ? p.xp + (size_t)m * DM : p.xs + (size_t)(m - MP) * DM) + lane;
#pragma unroll
                    for (int j = 0; j < 4; ++j) v[r][j] = xr[64 * j]; } }
#pragma unroll
            for (int r = 0; r < 4; ++r) { const int m = m0 + r * NGW;
                if (m < MREAL) { float s = 0.f; u32x2* o8 = (u32x2*)(XB + (size_t)m * DM) + lane;
#pragma unroll
                    for (int j = 0; j < 4; ++j) { s += (v[r][j][0] * v[r][j][0] + v[r][j][1] * v[r][j][1]) + (v[r][j][2] * v[r][j][2] + v[r][j][3] * v[r][j][3]);
                        u32x2 w; w.x = cvt_pk_bf16(v[r][j][0], v[r][j][1]); w.y = cvt_pk_bf16(v[r][j][2], v[r][j][3]); o8[64 * j] = w; }
                    s = wave_sum(s);
                    if (lane == 0) ssq[m] = s; } }
        }
    }
}

#define XB_TMO      128
#define XB_XCNT(j)  (256  + 64 * (j))
#define XB_XSUB(j)  (1280 + 64 * (j))
#define XB_XGEN(j)  (2304 + 64 * (j))
#define XB_TOP      3328
#define XB_TOPGEN   3392
#define XCD_BAR_WORDS 3456
#define XB_SPIN_CAP (1u << 18)
__device__ __forceinline__ unsigned xb_ld(unsigned* p)              { return __hip_atomic_load(p, __ATOMIC_RELAXED, __HIP_MEMORY_SCOPE_AGENT); }
__device__ __forceinline__ unsigned xb_add(unsigned* p, unsigned v) { return __hip_atomic_fetch_add(p, v, __ATOMIC_RELAXED, __HIP_MEMORY_SCOPE_AGENT); }
__device__ __forceinline__ unsigned xb_xcc_id() { return (unsigned)__builtin_amdgcn_s_getreg((3 << 11) | 20) & 0xFu; }
#define XB_SPIN(cond, bar) do { unsigned _sp = 0; while (cond) { __builtin_amdgcn_s_sleep(1); \
    if ((++_sp & 255u) == 0u) { if (xb_ld(&(bar)[XB_TMO])) break; if (_sp > XB_SPIN_CAP) { atomicAdd(&(bar)[XB_TMO], 1u); break; } } } } while (0)
struct XcdBarrier { unsigned* bar; unsigned x; volatile LAS unsigned* st; };
__device__ __forceinline__ XcdBarrier xcd_barrier_post(unsigned* bar, volatile LAS unsigned* st) {
    XcdBarrier b; b.bar = bar; b.x = xb_xcc_id(); b.st = st;
    if (threadIdx.x == 0) (void)xb_add(&bar[XB_XCNT(b.x)], 1u);
    return b;
}
__device__ __forceinline__ void xcd_barrier_complete(unsigned* bar, unsigned x, unsigned& nloc, unsigned& nx) {
    const unsigned G = gridDim.x * gridDim.y * gridDim.z;
    unsigned sum, cnt, mine, sp = 0u;
    for (;;) {
        sum = 0u; cnt = 0u; mine = 0u;
#pragma unroll
        for (unsigned j = 0; j < 16; ++j) { const unsigned c = xb_ld(&bar[XB_XCNT(j)]); sum += c; cnt += (c > 0u) ? 1u : 0u; mine = (j == x) ? c : mine; }
        if (sum == G) break;
        __builtin_amdgcn_s_sleep(1);
        if ((++sp & 255u) == 0u) { if (xb_ld(&bar[XB_TMO])) break; if (sp > XB_SPIN_CAP) { atomicAdd(&bar[XB_TMO], 1u); break; } }
    }
    nloc = mine > 0u ? mine : 1u; nx = cnt > 0u ? cnt : 1u;
}
__device__ __forceinline__ void xcd_barrier(const XcdBarrier& b) {
    asm volatile("s_waitcnt vmcnt(0)" ::: "memory");
    __syncthreads();
    if (threadIdx.x == 0) {
        unsigned* bar = b.bar;
        __builtin_amdgcn_s_waitcnt(0);
        unsigned nloc = b.st[0], nx = b.st[1];
        if (nloc == 0u) { xcd_barrier_complete(bar, b.x, nloc, nx); b.st[0] = nloc; b.st[1] = nx; }
        const unsigned old = xb_add(&bar[XB_XSUB(b.x)], 1u);
        const unsigned gen = old / nloc;
        if (old + 1u == (gen + 1u) * nloc) {
            __builtin_amdgcn_fence(__ATOMIC_RELEASE, "agent");
            asm volatile("s_waitcnt vmcnt(0)" ::: "memory");
            const unsigned og = xb_add(&bar[XB_TOP], 1u);
            const unsigned tg = og / nx;
            if (og + 1u == (tg + 1u) * nx) xb_add(&bar[XB_TOPGEN], 1u);
            else XB_SPIN(xb_ld(&bar[XB_TOPGEN]) == tg, bar);
            __builtin_amdgcn_fence(__ATOMIC_ACQUIRE, "agent");
            xb_add(&bar[XB_XGEN(b.x)], 1u);
            asm volatile("s_waitcnt vmcnt(0)" ::: "memory");
        } else {
            XB_SPIN(xb_ld(&bar[XB_XGEN(b.x)]) == gen, bar);
            __builtin_amdgcn_fence(__ATOMIC_ACQUIRE, "agent");
            asm volatile("s_waitcnt vmcnt(0)" ::: "memory");
        }
    }
    __syncthreads();
}


__global__ void __launch_bounds__(512) mk_fwd(Params p0) {
    extern __shared__ __attribute__((aligned(16))) unsigned char lds_raw[];
    LAS unsigned char* lds = (LAS unsigned char*)lds_raw;
    cg::grid_group grid = cg::this_grid();
    const int G = gridDim.x, bx = blockIdx.x;

    if (threadIdx.x < 2) ((volatile LAS unsigned*)(lds + MISC_OFF))[threadIdx.x] = 0u;
    {
        unsigned* bar = (unsigned*)(p0.ws + WS_BAR); unsigned* ready = bar + 4096;
        if (bx == 0) {
            for (int i = threadIdx.x; i < XCD_BAR_WORDS; i += 512) __hip_atomic_store(bar + i, 0u, __ATOMIC_RELAXED, __HIP_MEMORY_SCOPE_AGENT);
            asm volatile("s_waitcnt vmcnt(0)" ::: "memory");
            __syncthreads();
            if (threadIdx.x == 0) { __builtin_amdgcn_fence(__ATOMIC_RELEASE, "agent"); __hip_atomic_store(ready, 0x13572468u, __ATOMIC_RELAXED, __HIP_MEMORY_SCOPE_AGENT); }
        } else {
            if (threadIdx.x == 0) { unsigned sp = 0; while (__hip_atomic_load(ready, __ATOMIC_RELAXED, __HIP_MEMORY_SCOPE_AGENT) != 0x13572468u && ++sp < (1u << 22)) __builtin_amdgcn_s_sleep(2);
                                    __builtin_amdgcn_fence(__ATOMIC_ACQUIRE, "agent"); }
        }
        __syncthreads();
    }
    const XcdBarrier xbar = xcd_barrier_post((unsigned*)(p0.ws + WS_BAR), (volatile LAS unsigned*)(lds + MISC_OFF));
    if (p0.ws == nullptr) grid.sync();
    for (int rep = 0; rep < REP_P0; ++rep) { prologue(p0, lds); xcd_barrier(xbar); }
    for (int rep = 0; rep < EXTRA_SYNC; ++rep) xcd_barrier(xbar);

#pragma unroll 1
    for (int l = 0; l < 2; ++l) {
        Params p = p0;
        { unsigned char* w_ = p0.ws; float* o_ = p0.out; asm volatile("" : "+s"(w_), "+s"(o_)); p.ws = w_; p.out = o_; }
        float* ssq = (float*)(p.ws + WS_SSQ);
        bf16_t* XB = (bf16_t*)(p.ws + WS_XB); bf16_t* AD = (bf16_t*)(p.ws + WS_AD); bf16_t* MIX = (bf16_t*)(p.ws + WS_MIX); bf16_t* PROJ = (bf16_t*)(p.ws + WS_PROJ); bf16_t* U = PROJ;
        const unsigned char* wb = p.ws + WS_W + (size_t)l * W_LAYER;
        for (int rep = 0; rep < REP_P1; ++rep) {
            pg8::Gemm g{XB, (const bf16_t*)(wb + WO_IN), DM, DM, DM};
            small_proj(p, l, G, bx);
            SchedPlain S; S.o.init(MP / 256, INW / 256, G, bx); S.tA = 256L * DM * 2; S.tB = 256L * DM * 2;
            EpiProj E{PROJ, ssq + (2 * l) * MPAD, p.gate_bias + l * 2048};
            pg8::gemm_phase(lds, g, S, E);
            if (l == 0) convert_weights_idle(p, lds, WI_IN, WI_L, (MP / 256) * (INW / 256), G, bx);
        }
        xcd_barrier(xbar);
        for (int rep = 0; rep < REP_P2; ++rep) {
            const int vcu = (G % 8 == 0) ? (bx % 8) * (G / 8) + bx / 8 : bx;
#pragma unroll 1
            for (int idx = vcu; idx < 16 + 256; idx += G) {
                if (idx < 16) attn_unit(p, l, lds, true, idx >> 1, 0, idx & 1);
                else { const int q = idx - 16; attn_macro(p, l, lds, q >> 7, q & 63, (q >> 6) & 1); }
            }
            if (l == 0 && (vcu >= 16 || G <= 16)) { int tid_ = threadIdx.x; asm volatile("" : "+v"(tid_));
                const int nw = G > 16 ? G - 16 : G; convert_weights(p, lds, WI_L, 2 * WI_L, ((G > 16 ? vcu - 16 : vcu) * 8) + __builtin_amdgcn_readfirstlane(tid_ >> 6), nw * 8); }
        }
        xcd_barrier(xbar);
        for (int rep = 0; rep < REP_P3; ++rep) {
            pg8::Gemm g{AD, (const bf16_t*)(wb + WO_MIX), DM, 512, 512};
            small_mix(p, l, lds, G, bx);
            SchedMix S; S.o.init(MP / 256, DM / 256, G, bx);
            EpiMix E{MIX, PROJ};
            pg8::gemm_phase(lds, g, S, E);
        }
        xcd_barrier(xbar);
        {
            pg8::Gemm g{MIX, (const bf16_t*)(wb + WO_OUT), DM, DM, DM};
            SchedPlain S; S.o.init(MP / 256, DM / 256, G, bx); S.tA = 256L * DM * 2; S.tB = 256L * DM * 2;
            if (l == 0) { small_res<true, false, 4>(p, lds, MIX, DM, (const bf16_t*)(wb + WO_OUT), DM, ssq + (2 * l + 1) * MPAD, G, bx);
                          EpiRes<true, false> E{p.xp, p.out, XB, ssq + (2 * l + 1) * MPAD}; pg8::gemm_phase(lds, g, S, E); }
            else        { small_res<false, false, 4>(p, lds, MIX, DM, (const bf16_t*)(wb + WO_OUT), DM, ssq + (2 * l + 1) * MPAD, G, bx);
                          EpiRes<false, false> E{p.xp, p.out, XB, ssq + (2 * l + 1) * MPAD}; pg8::gemm_phase(lds, g, S, E); }
        }
        xcd_barrier(xbar);
        for (int rep = 0; rep < REP_P5; ++rep) {
            pg8::Gemm g{XB, (const bf16_t*)(wb + WO_UP), DM, DM, DM};
            small_up(p, l, lds, G, bx);
            SchedPlain S; S.o.init(MP / 256, FF2 / 256, G, bx); S.tA = 256L * DM * 2; S.tB = 256L * DM * 2;
            EpiUpConv E{U, ssq + (2 * l + 1) * MPAD, p.conv_w + (size_t)l * 3 * FF2, p.conv_b + (size_t)l * FF2, p.out + O_CP + (size_t)l * 2 * 2 * FF2, (LAS float*)(lds + XCH_OFF), (float*)(p.ws + WS_HALO)};
            pg8::gemm_phase(lds, g, S, E);
        }
        xcd_barrier(xbar);
        {
            pg8::Gemm g{U, (const bf16_t*)(wb + WO_DOWN), FF, FF, FF};
            SchedPlain S; S.o.init(MP / 256, DM / 256, G, bx); S.tA = 256L * FF * 2; S.tB = 256L * FF * 2;
            { Unit uu; for (int i = 0; S.next(i, uu); ++i) conv_fixup(p, l, uu.pm); asm volatile("s_waitcnt vmcnt(0)" ::: "memory"); __syncthreads(); }
            for (int rep = 0; rep < DRY_P6; ++rep) { EpiNone E0{ssq}; pg8::gemm_phase(lds, g, S, E0); }
            if (l == 0) { small_res<false, false, 11>(p, lds, U, FF, (const bf16_t*)(wb + WO_DOWN), FF, ssq + 2 * MPAD, G, bx);
                          EpiRes<false, false> E{p.xp, p.out, XB, ssq + 2 * MPAD}; pg8::gemm_phase(lds, g, S, E); }
            else        { small_res<false, true, 11>(p, lds, U, FF, (const bf16_t*)(wb + WO_DOWN), FF, nullptr, G, bx);
                          EpiRes<false, true> E{p.xp, p.out, XB, nullptr}; pg8::gemm_phase(lds, g, S, E); }
        }
        if (l == 0) xcd_barrier(xbar);
    }
    if (bx == 0 && threadIdx.x == 0) __hip_atomic_store((unsigned*)(p0.ws + WS_BAR) + 4096, 0u, __ATOMIC_RELAXED, __HIP_MEMORY_SCOPE_AGENT);
}

extern "C" void kernel_launch(void* const* d_in, const int* in_sizes, int n_in, void* d_out, int out_size, void* d_ws, size_t ws_size, hipStream_t stream) {
    static int grid_blocks = 0;
    if (!grid_blocks) {
        int dev = 0, cus = 0, per_cu = 0;
        hipGetDevice(&dev);
        hipDeviceGetAttribute(&cus, hipDeviceAttributeMultiprocessorCount, dev);
        hipFuncSetAttribute((const void*)mk_fwd, hipFuncAttributeMaxDynamicSharedMemorySize, LDS_BYTES);
        hipOccupancyMaxActiveBlocksPerMultiprocessor(&per_cu, (const void*)mk_fwd, 512, LDS_BYTES);
        if (per_cu < 1) { fprintf(stderr, "kernel_launch: occupancy query reports %d blocks per CU\n", per_cu); per_cu = 1; }
        if (per_cu > 1) per_cu = 1;
        grid_blocks = cus * per_cu;
    }
    Params p{};
    const float** pp = (const float**)&p;
    for (int i = 0; i < 22; ++i) pp[i] = (const float*)d_in[i];
    p.out = (float*)d_out; p.ws = (unsigned char*)d_ws;
    void* args[] = {&p};
    hipError_t e = hipLaunchCooperativeKernel((const void*)mk_fwd, dim3(grid_blocks), dim3(512), args, LDS_BYTES, stream);
    if (e != hipSuccess) fprintf(stderr, "cooperative launch failed: %s (grid %d)\n", hipGetErrorString(e), grid_blocks);
}
```

```cpp
#include <hip/hip_runtime.h>
#include <hip/hip_cooperative_groups.h>
#include <cstdio>
#include <cstdint>
namespace cg = cooperative_groups;

#define LAS __attribute__((address_space(3)))
typedef unsigned short bf16_t;
typedef short bf16x8 __attribute__((ext_vector_type(8)));
typedef float f32x4 __attribute__((ext_vector_type(4)));
typedef float f32x2 __attribute__((ext_vector_type(2)));
typedef float f32x16 __attribute__((ext_vector_type(16)));
typedef unsigned u32x4 __attribute__((ext_vector_type(4)));
typedef unsigned u32x2 __attribute__((ext_vector_type(2)));

constexpr int DM = 1024, SEQ = 16384, NB = 2, MP = NB * SEQ, MS = 128, MREAL = MP + MS, MPAD = 33024;
constexpr int INW = 3328, FF = 2816, FF2 = 5632;
constexpr float EPS = 1e-6f, LOG2E = 1.4426950408889634f;
constexpr size_t O_Y = 0, O_KP = 33685504, O_VP = 33751040, O_PP = 33816576, O_CP = 33847296, O_KS = 33892352, O_VS = 34154496, O_PS = 34416640, O_CS = 34539520;
constexpr size_t MiB = 1u << 20;
constexpr size_t WS_SSQ = 0;
constexpr size_t WS_BAR = 768 * 1024;
constexpr int MISC_OFF = 147456 - 64;
constexpr size_t WS_W = 1 * MiB, W_LAYER = 27 * MiB;
constexpr size_t WO_IN = 0, WO_MIX = 6 * MiB + 512 * 1024, WO_OUT = WO_MIX + 2 * MiB, WO_UP = WO_OUT + 2 * MiB, WO_DOWN = WO_UP + 11 * MiB;
constexpr size_t WS_XB = 56 * MiB, WS_AD = 121 * MiB, WS_MIX = 186 * MiB, WS_PROJ = 251 * MiB;
constexpr size_t WS_HALO = 462 * MiB;
constexpr int LDS_BYTES = 147456, XCH_OFF = 131072;
#ifndef REP_P0
#define REP_P0 1
#endif
#ifndef REP_P1
#define REP_P1 1
#endif
#ifndef REP_P2
#define REP_P2 1
#endif
#ifndef REP_P3
#define REP_P3 1
#endif
#ifndef REP_P5
#define REP_P5 1
#endif
#ifndef DRY_P6
#define DRY_P6 0
#endif
#ifndef EXTRA_SYNC
#define EXTRA_SYNC 0
#endif

struct Params {
    const float *xp, *xs, *cache_k, *cache_v, *state_pool, *state_conv, *norm_mix, *w_in, *q_norm, *k_norm, *sinks, *w_pool, *pool_scale,
        *w_br_attn, *w_br_pool, *gate_bias, *w_out, *norm_ffn, *w_up, *conv_w, *conv_b, *w_down;
    float* out; unsigned char* ws;
};

__device__ __forceinline__ unsigned cvt_pk_bf16(float lo, float hi) { unsigned r; asm volatile("v_cvt_pk_bf16_f32 %0, %1, %2" : "=v"(r) : "v"(lo), "v"(hi)); return r; }
__device__ __forceinline__ float bf_lo(unsigned u) { return __builtin_bit_cast(float, u << 16); }
__device__ __forceinline__ float bf_hi(unsigned u) { return __builtin_bit_cast(float, u & 0xffff0000u); }
__device__ __forceinline__ void unpack8(const u32x4 w, float* f) { f[0] = bf_lo(w.x); f[1] = bf_hi(w.x); f[2] = bf_lo(w.y); f[3] = bf_hi(w.y); f[4] = bf_lo(w.z); f[5] = bf_hi(w.z); f[6] = bf_lo(w.w); f[7] = bf_hi(w.w); }
__device__ __forceinline__ u32x4 pack8(const float* f) { u32x4 w; w.x = cvt_pk_bf16(f[0], f[1]); w.y = cvt_pk_bf16(f[2], f[3]); w.z = cvt_pk_bf16(f[4], f[5]); w.w = cvt_pk_bf16(f[6], f[7]); return w; }
__device__ __forceinline__ float ror1(float x) { return __builtin_bit_cast(float, __builtin_amdgcn_update_dpp(0, __builtin_bit_cast(int, x), 0x121, 0xf, 0xf, false)); }
__device__ __forceinline__ float ror2(float x) { return __builtin_bit_cast(float, __builtin_amdgcn_update_dpp(0, __builtin_bit_cast(int, x), 0x122, 0xf, 0xf, false)); }
__device__ __forceinline__ f32x2 gelu_pk(f32x2 v) {
    const f32x2 av = __builtin_elementwise_abs(v), d = av * 0.2316418882f + 1.0f;
    f32x2 t; t.x = __builtin_amdgcn_rcpf(d.x); t.y = __builtin_amdgcn_rcpf(d.y);
    f32x2 q = t * 0.5307027145f + (-0.7265760135f); q = q * t + 0.7107068705f; q = q * t + (-0.142248368f); q = q * t + 0.127414796f; q = q * t;
    const f32x2 s = (v * v) * (-0.72134752044f);
    f32x2 e; e.x = __builtin_amdgcn_exp2f(s.x); e.y = __builtin_amdgcn_exp2f(s.y);
    const f32x2 m = v * (q * e), r = v - m;
    f32x2 o; o.x = v.x < 0.f ? m.x : r.x; o.y = v.y < 0.f ? m.y : r.y; return o;
}

namespace pg8 {
constexpr int BM = 256, BK = 64, HALF = 128, HTB = HALF * BK * 2, STAGE_BYTES = 8 * HTB, NXCD = 8, WGM = 8;
__host__ __device__ __forceinline__ int lds_byte(int r, int c) { const int st = (r >> 4) * 2 + (c >> 5), rr = r & 15, cc = c & 31, ob = rr * 64 + cc * 2; return st * 1024 + (ob ^ (((ob >> 9) & 1) << 5)); }
__host__ __device__ __forceinline__ void stage_rc(int b, int& R, int& C) { const int st = b / 1024, sb = b % 1024, swz = sb ^ (((sb >> 9) & 1) << 5); R = (st >> 1) * 16 + swz / 64; C = (st & 1) * 32 + (swz % 64) / 2; }
__host__ __device__ __forceinline__ int perm32(int rho) { const int n = rho >> 4, i = rho & 15; return 8 * (i >> 2) + 4 * n + (i & 3); }

struct Unit { int pm, pn, z; };
struct Gemm { const bf16_t* A; const bf16_t* Bt; int lda, ldb, K; };

struct TileOrder {
    int nM, nN, nwg, G, c;
    __device__ void init(int nM_, int nN_, int G_, int c_) { nM = nM_; nN = nN_; nwg = nM * nN; G = G_; c = c_; }
    __device__ bool tile(int i, Unit& u) const {
        const long L = (long)i * G + c; if (L >= nwg) return false;
        int wgid = (int)L; { const int q = nwg / NXCD, r = nwg % NXCD, xcd = wgid % NXCD, off = wgid / NXCD; wgid = (xcd < r ? xcd * (q + 1) : r * (q + 1) + (xcd - r) * q) + off; }
        const int nig = WGM * nN, gid = wgid / nig, fm = gid * WGM, gsz = (nM - fm) < WGM ? (nM - fm) : WGM;
        u.pm = fm + ((wgid % nig) % gsz); u.pn = (wgid % nig) / gsz; return true;
    }
};

template <class E> __device__ __forceinline__ auto epi_keep_acc(const E& e, const Unit& u) -> decltype(e.keep_acc(u)) { return e.keep_acc(u); }
__device__ __forceinline__ bool epi_keep_acc(...) { return false; }
template <class Epi, class Sched>
__device__ __forceinline__ void gemm_phase(LAS unsigned char* lds, const Gemm g, const Sched& S, const Epi& E) {
    int tid = threadIdx.x; asm volatile("" : "+v"(tid));
    const int wid = __builtin_amdgcn_readfirstlane(tid >> 6), lane = tid & 63, wr = wid >> 2, wc = wid & 3, fr = lane & 15, fq = lane >> 4;
    const int K = g.K, nt = K / BK;
    unsigned voffA[2], voffB[2];
#pragma unroll
    for (int i = 0; i < 2; ++i) { int R, C; stage_rc(tid * 16 + i * 8192, R, C); const int Rb = Epi::PERM ? ((R & ~31) + perm32(R & 31)) : R;
        voffA[i] = (unsigned)(R * g.lda + C) * 2u; voffB[i] = (unsigned)(Rb * g.ldb + C) * 2u; }
    const size_t kstep = (size_t)(BK * 2);
    const size_t hstepA = (size_t)HALF * g.lda * 2, hstepB = (size_t)HALF * g.ldb * 2;
    const unsigned ldsw = (unsigned)wid * 1024u;
    const int aoff = lds_byte(wr * 64 + fr, fq * 8), boff = lds_byte(wc * 32 + fr, fq * 8);
#define PG8_SA(b, h) (((b) * 2 + (h)) * HTB)
#define PG8_SB(b, h) ((4 + (b) * 2 + (h)) * HTB)
#define PG8_STAGE(bufoff, gbase, voff) do { _Pragma("unroll") for (int _i = 0; _i < 2; ++_i) \
        __builtin_amdgcn_global_load_lds((const unsigned*)((const char*)(gbase) + (voff)[_i]), (LAS unsigned*)(lds + (bufoff) + ldsw + _i * 8192), 16, 0, 0); } while (0)
#define PG8_LDA(dst, b, h) do { _Pragma("unroll") for (int m = 0; m < 4; ++m) _Pragma("unroll") for (int k = 0; k < 2; ++k) dst[m][k] = *(const LAS bf16x8*)(lds + PG8_SA(b, h) + aoff + m * 2048 + k * 1024); } while (0)
#define PG8_LDB(dst, b, h) do { _Pragma("unroll") for (int n = 0; n < 2; ++n) _Pragma("unroll") for (int k = 0; k < 2; ++k) dst[n][k] = *(const LAS bf16x8*)(lds + PG8_SB(b, h) + boff + n * 2048 + k * 1024); } while (0)
#define PG8_MMA(ai, bj, At, Bt) do { __builtin_amdgcn_s_setprio(1); _Pragma("unroll") for (int m = 0; m < 4; ++m) _Pragma("unroll") for (int n = 0; n < 2; ++n) _Pragma("unroll") for (int k = 0; k < 2; ++k) \
        acc[ai][bj][m][n] = __builtin_amdgcn_mfma_f32_16x16x32_bf16(Bt[n][k], At[m][k], acc[ai][bj][m][n], 0, 0, 0); __builtin_amdgcn_s_setprio(0); } while (0)
#define PG8_WAIT_V(n) asm volatile("s_waitcnt vmcnt(" #n ")" ::: "memory")
#define PG8_WAIT_L(n) asm volatile("s_waitcnt lgkmcnt(" #n ")" ::: "memory")
#define PG8_BAR __builtin_amdgcn_s_barrier()
#define PG8_SCHED __builtin_amdgcn_sched_barrier(0)
    Unit cur, nxt; int ui = 0;
    if (!S.next(0, cur)) return;
    f32x4 acc[2][2][4][2];
#pragma unroll
    for (int a = 0; a < 2; ++a)
#pragma unroll
        for (int b = 0; b < 2; ++b)
#pragma unroll
            for (int m = 0; m < 4; ++m)
#pragma unroll
                for (int n = 0; n < 2; ++n) acc[a][b][m][n] = (f32x4){0.f, 0.f, 0.f, 0.f};
    bf16x8 At[4][2], B0[2][2], B1[2][2];
    const char* cA = (const char*)g.A + S.a_off(cur); const char* cB = (const char*)g.Bt + S.b_off(cur);
    PG8_STAGE(PG8_SB(0, 0), cB, voffB); PG8_STAGE(PG8_SB(0, 1), cB + hstepB, voffB); PG8_STAGE(PG8_SA(0, 0), cA, voffA); PG8_STAGE(PG8_SA(0, 1), cA + hstepA, voffA);
    if (wr == 1) PG8_BAR;
    PG8_WAIT_V(2); PG8_BAR;
    PG8_STAGE(PG8_SB(1, 0), cB + kstep, voffB); PG8_STAGE(PG8_SA(1, 0), cA + kstep, voffA); PG8_STAGE(PG8_SB(1, 1), cB + hstepB + kstep, voffB);
    PG8_WAIT_V(6); PG8_BAR;
    for (;;) {
        const bool has_next = S.next(ui + 1, nxt);
        const char* nA = has_next ? (const char*)g.A + S.a_off(nxt) : cA; const char* nB = has_next ? (const char*)g.Bt + S.b_off(nxt) : cB;
        for (int t = 0; t < nt; t += 2) {
            const bool last = (t == nt - 2);
            const char* a1 = cA + (size_t)(t + 1) * kstep;
            const char* a2 = last ? nA : cA + (size_t)(t + 2) * kstep; const char* b2 = last ? nB : cB + (size_t)(t + 2) * kstep;
            const char* a3 = a2 + kstep; const char* b3 = b2 + kstep;
            PG8_LDB(B0, 0, 0); PG8_LDB(B1, 0, 1); PG8_SCHED; PG8_LDA(At, 0, 0); PG8_STAGE(PG8_SA(1, 1), a1 + hstepA, voffA);
            PG8_WAIT_V(8); PG8_WAIT_L(0); PG8_BAR; PG8_MMA(0, 0, At, B0); PG8_MMA(0, 1, At, B1); PG8_BAR; PG8_SCHED;
            PG8_LDA(At, 0, 1); PG8_STAGE(PG8_SB(0, 0), b2, voffB); PG8_STAGE(PG8_SB(0, 1), b2 + hstepB, voffB); PG8_STAGE(PG8_SA(0, 0), a2, voffA);
            PG8_WAIT_V(8); PG8_WAIT_L(0); PG8_BAR; PG8_MMA(1, 0, At, B0); PG8_MMA(1, 1, At, B1); PG8_BAR; PG8_SCHED;
            PG8_LDB(B0, 1, 0); PG8_LDB(B1, 1, 1); PG8_SCHED; PG8_LDA(At, 1, 0); PG8_STAGE(PG8_SA(0, 1), a2 + hstepA, voffA);
            PG8_WAIT_V(8); PG8_WAIT_L(0); PG8_BAR; PG8_MMA(0, 0, At, B0); PG8_MMA(0, 1, At, B1); PG8_BAR; PG8_SCHED;
            PG8_LDA(At, 1, 1); PG8_STAGE(PG8_SB(1, 0), b3, voffB); PG8_STAGE(PG8_SB(1, 1), b3 + hstepB, voffB); PG8_STAGE(PG8_SA(1, 0), a3, voffA);
            PG8_WAIT_V(8); PG8_WAIT_L(0); PG8_BAR; PG8_MMA(1, 0, At, B0); PG8_MMA(1, 1, At, B1); PG8_BAR; PG8_SCHED;
        }
        if (wr == 0) PG8_BAR;
        { int fr_ = fr, fq_ = fq; asm volatile("" : "+v"(fr_), "+v"(fq_));
          E(acc, cur, wr, wc, fr_, fq_); }
        if (!has_next) break;
        if (!epi_keep_acc(E, cur)) {
#pragma unroll
        for (int a = 0; a < 2; ++a)
#pragma unroll
            for (int b = 0; b < 2; ++b)
#pragma unroll
                for (int m = 0; m < 4; ++m)
#pragma unroll
                    for (int n = 0; n < 2; ++n) acc[a][b][m][n] = (f32x4){0.f, 0.f, 0.f, 0.f};
        }
        cur = nxt; cA = nA; cB = nB; ++ui;
        if (wr == 1) PG8_BAR;
    }
    PG8_WAIT_V(0);
    PG8_BAR;
#undef PG8_SA
#undef PG8_SB
#undef PG8_STAGE
#undef PG8_LDA
#undef PG8_LDB
#undef PG8_MMA
#undef PG8_WAIT_V
#undef PG8_WAIT_L
#undef PG8_BAR
#undef PG8_SCHED
}
}
using pg8::Unit;
typedef f32x4 AccT[2][2][4][2];

struct SchedPlain {
    pg8::TileOrder o; long tA, tB;
    __device__ __forceinline__ bool next(int i, Unit& u) const { u.z = 0; return o.tile(i, u); }
    __device__ __forceinline__ long a_off(const Unit& u) const { return (long)u.pm * tA; }
    __device__ __forceinline__ long b_off(const Unit& u) const { return (long)u.pn * tB; }
};
struct SchedMix {
    pg8::TileOrder o;
    __device__ __forceinline__ bool next(int i, Unit& u) const { u.z = i & 1; return o.tile(i >> 1, u); }
    __device__ __forceinline__ long a_off(const Unit& u) const { return (long)u.pm * 256 * DM * 2 + (long)u.z * 512 * 2; }
    __device__ __forceinline__ long b_off(const Unit& u) const { return ((long)u.z * 1024 + (long)u.pn * 256) * 512 * 2; }
};
struct SchedUp {
    pg8::TileOrder o;
    __device__ __forceinline__ bool next(int i, Unit& u) const { u.z = 0; return o.tile(i, u); }
    __device__ __forceinline__ long a_off(const Unit& u) const { const int ti = u.pm; const int b = ti / 65, i = ti % 65; return ((long)b * SEQ + 254 * i - 2) * DM * 2; }
    __device__ __forceinline__ long b_off(const Unit& u) const { return (long)u.pn * 256 * DM * 2; }
};

struct EpiProj {
    static constexpr bool PERM = true;
    bf16_t* P; const float* ssq; const float* gbias;
    __device__ __forceinline__ void operator()(AccT& acc, const Unit& u, int wr, int wc, int fr, int fq) const {
        const bool gate = u.pn >= 5;
        const int col0 = u.pn * 256 + wc * 32 + 8 * fq;
        f32x4 gb[2][2];
#pragma unroll
        for (int bj = 0; bj < 2; ++bj)
#pragma unroll
            for (int n = 0; n < 2; ++n) gb[bj][n] = gate ? *(const f32x4*)(gbias + (col0 - 1280) + bj * 128 + 4 * n) : (f32x4){0.f, 0.f, 0.f, 0.f};
        float rsv[2][4];
#pragma unroll
        for (int ai = 0; ai < 2; ++ai)
#pragma unroll
            for (int m = 0; m < 4; ++m) rsv[ai][m] = ssq[u.pm * 256 + ai * 128 + wr * 64 + m * 16 + fr];
#pragma unroll
        for (int ai = 0; ai < 2; ++ai)
#pragma unroll
            for (int m = 0; m < 4; ++m) {
                const int row = u.pm * 256 + ai * 128 + wr * 64 + m * 16 + fr;
                const float rs = __builtin_amdgcn_rsqf(rsv[ai][m] * (1.0f / 1024.0f) + EPS);
                bf16_t* rowp = P + (size_t)row * INW + col0;
#pragma unroll
                for (int bj = 0; bj < 2; ++bj) {
                    float v[8];
#pragma unroll
                    for (int n = 0; n < 2; ++n)
#pragma unroll
                        for (int j = 0; j < 4; ++j) {
                            float x = acc[ai][bj][m][n][j] * rs;
                            if (gate) { x += gb[bj][n][j]; x = __builtin_amdgcn_rcpf(1.0f + __builtin_amdgcn_exp2f(-LOG2E * x)); }
                            v[n * 4 + j] = x;
                        }
                    *(u32x4*)(rowp + bj * 128) = pack8(v);
                }
            }
    }
};
struct EpiMix {
    static constexpr bool PERM = true;
    bf16_t* MIX; const bf16_t* P;
    __device__ __forceinline__ bool keep_acc(const Unit& u) const { return u.z == 0; }
    __device__ __forceinline__ void operator()(AccT& acc, const Unit& u, int wr, int wc, int fr, int fq) const {
        const int col0 = u.pn * 256 + wc * 32 + 8 * fq;
        const char* Pb = (const char*)P;
        u32x4 gw[2][4][2];
        if (u.z == 0) {
#pragma unroll
            for (int ai = 0; ai < 2; ++ai)
#pragma unroll
                for (int m = 0; m < 4; ++m)
#pragma unroll
                    for (int bj = 0; bj < 2; ++bj) gw[ai][m][bj] = *(const u32x4*)(Pb + (unsigned)(((u.pm * 256 + ai * 128 + wr * 64 + m * 16 + fr) * INW + col0 + bj * 128 + 1280) * 2));
#pragma unroll
            for (int ai = 0; ai < 2; ++ai)
#pragma unroll
                for (int m = 0; m < 4; ++m)
#pragma unroll
                    for (int bj = 0; bj < 2; ++bj) { float g0[8]; unpack8(gw[ai][m][bj], g0);
#pragma unroll
                        for (int n = 0; n < 2; ++n)
#pragma unroll
                            for (int j = 0; j < 4; ++j) acc[ai][bj][m][n][j] *= g0[n * 4 + j]; }
        }
#pragma unroll
        for (int ai = 0; ai < 2; ++ai)
#pragma unroll
            for (int m = 0; m < 4; ++m)
#pragma unroll
                for (int bj = 0; bj < 2; ++bj) gw[ai][m][bj] = *(const u32x4*)(Pb + (unsigned)(((u.pm * 256 + ai * 128 + wr * 64 + m * 16 + fr) * INW + col0 + bj * 128 + 2304) * 2));
#pragma unroll
        for (int ai = 0; ai < 2; ++ai)
#pragma unroll
            for (int m = 0; m < 4; ++m)
#pragma unroll
                for (int bj = 0; bj < 2; ++bj) {
                    const int row = u.pm * 256 + ai * 128 + wr * 64 + m * 16 + fr, col = col0 + bj * 128;
                    float g1[8]; unpack8(gw[ai][m][bj], g1);
                    if (u.z == 0) {
#pragma unroll
                        for (int n = 0; n < 2; ++n)
#pragma unroll
                            for (int j = 0; j < 4; ++j) acc[ai][bj][m][n][j] *= __builtin_amdgcn_rcpf(__builtin_fmaxf(g1[n * 4 + j], 1.0e-30f));
                    } else {
                        float v[8];
#pragma unroll
                        for (int n = 0; n < 2; ++n)
#pragma unroll
                            for (int j = 0; j < 4; ++j) v[n * 4 + j] = acc[ai][bj][m][n][j] * g1[n * 4 + j];
                        *(u32x4*)((char*)MIX + (unsigned)((row * DM + col) * 2)) = pack8(v);
                    }
                }
    }
};
template <bool RES_F32, bool OUT_F32> struct EpiRes {
    static constexpr bool PERM = true;
    const float* res; float* out; bf16_t* XB; float* ssq_next;
    __device__ __forceinline__ void finish(const f32x4 x0, const f32x4 x1, int row, int col, float& s) const {
        if (OUT_F32) { *(f32x4*)(out + (size_t)row * DM + col) = x0; *(f32x4*)(out + (size_t)row * DM + col + 4) = x1; }
        else { u32x4 w; w.x = cvt_pk_bf16(x0[0], x0[1]); w.y = cvt_pk_bf16(x0[2], x0[3]); w.z = cvt_pk_bf16(x1[0], x1[1]); w.w = cvt_pk_bf16(x1[2], x1[3]); *(u32x4*)(XB + (size_t)row * DM + col) = w; }
        s += (x0[0] * x0[0] + x0[1] * x0[1]) + (x0[2] * x0[2] + x0[3] * x0[3]) + (x1[0] * x1[0] + x1[1] * x1[1]) + (x1[2] * x1[2] + x1[3] * x1[3]);
    }
    __device__ __forceinline__ void operator()(AccT& acc, const Unit& u, int wr, int wc, int fr, int fq) const {
        const int col0 = u.pn * 256 + wc * 32 + 8 * fq;
        if constexpr (!RES_F32) {
            u32x4 rb[2][4][2];
#pragma unroll
            for (int ai = 0; ai < 2; ++ai)
#pragma unroll
                for (int m = 0; m < 4; ++m)
#pragma unroll
                    for (int bj = 0; bj < 2; ++bj) rb[ai][m][bj] = *(const u32x4*)((const char*)XB + (unsigned)(((u.pm * 256 + ai * 128 + wr * 64 + m * 16 + fr) * DM + col0 + bj * 128) * 2));
#pragma unroll
            for (int ai = 0; ai < 2; ++ai)
#pragma unroll
                for (int m = 0; m < 4; ++m) {
                    const int row = u.pm * 256 + ai * 128 + wr * 64 + m * 16 + fr; float s = 0.f;
#pragma unroll
                    for (int bj = 0; bj < 2; ++bj) { const u32x4 w = rb[ai][m][bj];
                        finish((f32x4){bf_lo(w.x), bf_hi(w.x), bf_lo(w.y), bf_hi(w.y)} + acc[ai][bj][m][0], (f32x4){bf_lo(w.z), bf_hi(w.z), bf_lo(w.w), bf_hi(w.w)} + acc[ai][bj][m][1], row, col0 + bj * 128, s); }
                    if (!OUT_F32) { s += __shfl_xor(s, 16); s += __shfl_xor(s, 32); if (fq == 0) atomicAdd(ssq_next + row, s); }
                }
        } else {
#pragma unroll
            for (int ai = 0; ai < 2; ++ai) {
                f32x4 rv[4][2][2];
#pragma unroll
                for (int m = 0; m < 4; ++m)
#pragma unroll
                    for (int bj = 0; bj < 2; ++bj) { const size_t o = (size_t)(u.pm * 256 + ai * 128 + wr * 64 + m * 16 + fr) * DM + col0 + bj * 128; rv[m][bj][0] = *(const f32x4*)(res + o); rv[m][bj][1] = *(const f32x4*)(res + o + 4); }
#pragma unroll
                for (int m = 0; m < 4; ++m) {
                    const int row = u.pm * 256 + ai * 128 + wr * 64 + m * 16 + fr; float s = 0.f;
#pragma unroll
                    for (int bj = 0; bj < 2; ++bj) finish(rv[m][bj][0] + acc[ai][bj][m][0], rv[m][bj][1] + acc[ai][bj][m][1], row, col0 + bj * 128, s);
                    if (!OUT_F32) { s += __shfl_xor(s, 16); s += __shfl_xor(s, 32); if (fq == 0) atomicAdd(ssq_next + row, s); }
                }
            }
        }
    }
};
struct EpiNone { static constexpr bool PERM = true; __device__ __forceinline__ void operator()(AccT& acc, const Unit& u, int wr, int wc, int fr, int fq) const { float s = 0.f;
#pragma unroll
        for (int ai = 0; ai < 2; ++ai)
#pragma unroll
            for (int bj = 0; bj < 2; ++bj)
#pragma unroll
                for (int m = 0; m < 4; ++m)
#pragma unroll
                    for (int n = 0; n < 2; ++n) s += acc[ai][bj][m][n][0] + acc[ai][bj][m][n][1] + acc[ai][bj][m][n][2] + acc[ai][bj][m][n][3];
        if (s == 123.456f) *sink = s; }
    float* sink; };
struct EpiUpConv {
    static constexpr bool PERM = true;
    bf16_t* U; const float* ssq; const float* cw; const float* cb; float* conv_p; LAS float* xch; float* halo;
    __device__ __forceinline__ void operator()(AccT& acc, const Unit& u, int wr, int wc, int fr, int fq) const {
        const int b = u.pm >> 6, tstart = (u.pm & 63) * 256;
        const long arow0 = (long)u.pm * 256;
        const int colg0 = u.pn * 128 + wc * 32 + fq * 8;
        f32x4 cwg[2][3], cwv[2][3], cbg[2], cbv[2];
#pragma unroll
        for (int n = 0; n < 1; ++n) { const int colg = colg0 + n * 4, colv = FF + colg;
#pragma unroll
            for (int j = 0; j < 3; ++j) { cwg[n][j] = *(const f32x4*)(cw + j * FF2 + colg); cwv[n][j] = *(const f32x4*)(cw + j * FF2 + colv); }
            cbg[n] = *(const f32x4*)(cb + colg); cbv[n] = *(const f32x4*)(cb + colv); }
        float sq[2][4];
#pragma unroll
        for (int ai = 0; ai < 2; ++ai)
#pragma unroll
            for (int m = 0; m < 4; ++m) { const int rl = ai * 128 + wr * 64 + m * 16 + fr, t = tstart + rl; sq[ai][m] = ssq[arow0 + rl]; }
#pragma unroll
        for (int ai = 0; ai < 2; ++ai)
#pragma unroll
            for (int m = 0; m < 4; ++m) {
                const int rl = ai * 128 + wr * 64 + m * 16 + fr;
                const int t = tstart + rl;
                const float rs = __builtin_amdgcn_rsqf(sq[ai][m] * (1.0f / 1024.0f) + EPS);
#pragma unroll
                for (int bj = 0; bj < 2; ++bj)
#pragma unroll
                    for (int n = 0; n < 2; ++n) acc[ai][bj][m][n] = acc[ai][bj][m][n] * rs;
            }
        if (fr >= 14) {
#pragma unroll
            for (int ai = 0; ai < 2; ++ai)
#pragma unroll
                for (int bj = 0; bj < 2; ++bj)
#pragma unroll
                    for (int n = 0; n < 2; ++n)
                        *(LAS f32x4*)(xch + (((ai * 2 + wr) * 2 + (fr - 14)) * 256 + bj * 128 + wc * 32 + fq * 8 + n * 4)) = acc[ai][bj][3][n];
        }
        asm volatile("s_waitcnt lgkmcnt(0)" ::: "memory"); __builtin_amdgcn_s_barrier(); asm volatile("" ::: "memory");
        u32x2 stash[2][4];
#pragma unroll
        for (int n = 0; n < 2; ++n) {
            const int colg = colg0 + n * 4, colv = FF + colg;
            if (n == 1) {
#pragma unroll
                for (int j = 0; j < 3; ++j) { cwg[1][j] = *(const f32x4*)(cw + j * FF2 + colg); cwv[1][j] = *(const f32x4*)(cw + j * FF2 + colv); }
                cbg[1] = *(const f32x4*)(cb + colg); cbv[1] = *(const f32x4*)(cb + colv); }
            const f32x4 w0g = cwg[n][0], w1g = cwg[n][1], w2g = cwg[n][2], bg = cbg[n];
            const f32x4 w0v = cwv[n][0], w1v = cwv[n][1], w2v = cwv[n][2], bv = cbv[n];
#pragma unroll
            for (int ai = 0; ai < 2; ++ai) {
                f32x4 hg = (f32x4){0.f, 0.f, 0.f, 0.f}, hv = hg;
                const int s = ai * 2 + wr;
                if (s > 0 && fr >= 14) {
                    hg = *(const LAS f32x4*)(xch + (((s - 1) * 2 + (fr - 14)) * 256 + wc * 32 + fq * 8 + n * 4));
                    hv = *(const LAS f32x4*)(xch + (((s - 1) * 2 + (fr - 14)) * 256 + 128 + wc * 32 + fq * 8 + n * 4));
                }
#pragma unroll
                for (int m = 0; m < 4; ++m) {
                    const int rl = ai * 128 + wr * 64 + m * 16 + fr;
                    const f32x4 cg_ = acc[ai][0][m][n], cv_ = acc[ai][1][m][n];
                    f32x4 p1g, p2g, p1v, p2v;
#pragma unroll
                    for (int j = 0; j < 4; ++j) {
                        p1g[j] = ror1(fr == 15 ? hg[j] : cg_[j]); p2g[j] = ror2(fr >= 14 ? hg[j] : cg_[j]);
                        p1v[j] = ror1(fr == 15 ? hv[j] : cv_[j]); p2v[j] = ror2(fr >= 14 ? hv[j] : cv_[j]);
                    }
                    const f32x4 hcg = bg + w0g * p2g + w1g * p1g + w2g * cg_;
                    const f32x4 hcv = bv + w0v * p2v + w1v * p1v + w2v * cv_;
                    const f32x2 ga = gelu_pk((f32x2){hcg[0], hcg[1]}), gb2 = gelu_pk((f32x2){hcg[2], hcg[3]});
                    u32x2 w; w.x = cvt_pk_bf16(ga.x * hcv[0], ga.y * hcv[1]); w.y = cvt_pk_bf16(gb2.x * hcv[2], gb2.y * hcv[3]);
                    const int t = tstart + rl;
                    if (n == 0) stash[ai][m] = w;
                    else if (rl >= 2) *(u32x4*)(U + (size_t)(arow0 + rl) * FF + colg0) = (u32x4){stash[ai][m].x, stash[ai][m].y, w.x, w.y};
                    if (rl < 2 || rl >= 254) { float* hp = halo + ((size_t)u.pm * 4 + (rl < 2 ? rl : rl - 252)) * FF2; *(f32x4*)(hp + colg) = cg_; *(f32x4*)(hp + colv) = cv_; }
                    if (t >= SEQ - 2) { float* cp = conv_p + (size_t)(b * 2 + (t - (SEQ - 2))) * FF2; *(f32x4*)(cp + colg) = cg_; *(f32x4*)(cp + colv) = cv_; }
                    hg = cg_; hv = cv_;
                    __builtin_amdgcn_sched_barrier(0);
                }
            }
        }
    }
};


__device__ __forceinline__ void conv_fixup(const Params& p, int l, int pm) {
    int tid = threadIdx.x; asm volatile("" : "+v"(tid));
    const float* halo = (const float*)(p.ws + WS_HALO); bf16_t* U = (bf16_t*)(p.ws + WS_PROJ);
    const float* cw = p.conv_w + (size_t)l * 3 * FF2; const float* cb = p.conv_b + (size_t)l * FF2;
    const bool first = (pm & 63) == 0;
#pragma unroll 1
    for (int q = tid; q < FF / 4; q += 512) {
        const int cg = 4 * q, cv = FF + cg;
        const f32x4 z = (f32x4){0.f, 0.f, 0.f, 0.f};
        const float* hp = halo + (size_t)(pm - 1) * 4 * FF2; const float* hc_ = halo + (size_t)pm * 4 * FF2;
        const f32x4 a2g = first ? z : *(const f32x4*)(hp + 2 * FF2 + cg), a2v = first ? z : *(const f32x4*)(hp + 2 * FF2 + cv);
        const f32x4 a1g = first ? z : *(const f32x4*)(hp + 3 * FF2 + cg), a1v = first ? z : *(const f32x4*)(hp + 3 * FF2 + cv);
        const f32x4 r0g = *(const f32x4*)(hc_ + cg), r0v = *(const f32x4*)(hc_ + cv), r1g = *(const f32x4*)(hc_ + FF2 + cg), r1v = *(const f32x4*)(hc_ + FF2 + cv);
        const f32x4 w0g = *(const f32x4*)(cw + cg), w1g = *(const f32x4*)(cw + FF2 + cg), w2g = *(const f32x4*)(cw + 2 * FF2 + cg), bg = *(const f32x4*)(cb + cg);
        const f32x4 w0v = *(const f32x4*)(cw + cv), w1v = *(const f32x4*)(cw + FF2 + cv), w2v = *(const f32x4*)(cw + 2 * FF2 + cv), bv = *(const f32x4*)(cb + cv);
#pragma unroll
        for (int r = 0; r < 2; ++r) {
            const f32x4 hcg = bg + w0g * (r == 0 ? a2g : a1g) + w1g * (r == 0 ? a1g : r0g) + w2g * (r == 0 ? r0g : r1g);
            const f32x4 hcv = bv + w0v * (r == 0 ? a2v : a1v) + w1v * (r == 0 ? a1v : r0v) + w2v * (r == 0 ? r0v : r1v);
            const f32x2 ga = gelu_pk((f32x2){hcg[0], hcg[1]}), gb2 = gelu_pk((f32x2){hcg[2], hcg[3]});
            u32x2 w; w.x = cvt_pk_bf16(ga.x * hcv[0], ga.y * hcv[1]); w.y = cvt_pk_bf16(gb2.x * hcv[2], gb2.y * hcv[3]);
            *(u32x2*)(U + (size_t)(pm * 256 + r) * FF + cg) = w;
        }
    }
}
__device__ __forceinline__ void conv_fixup2(const Params& p, int l, int pmA, int pmB) {
    int tid = threadIdx.x; asm volatile("" : "+v"(tid));
    const float* halo = (const float*)(p.ws + WS_HALO); bf16_t* U = (bf16_t*)(p.ws + WS_PROJ);
    const float* cw = p.conv_w + (size_t)l * 3 * FF2; const float* cb = p.conv_b + (size_t)l * FF2;
#pragma unroll 1
    for (int q = tid; q < FF / 4; q += 512) {
        const int cg = 4 * q, cv = FF + cg;
#pragma unroll
        for (int w2 = 0; w2 < 2; ++w2) { const int pm = w2 ? pmB : pmA; const bool first = (pm & 63) == 0;
        const f32x4 z = (f32x4){0.f, 0.f, 0.f, 0.f};
        const float* hp = halo + (size_t)(pm - 1) * 4 * FF2; const float* hc_ = halo + (size_t)pm * 4 * FF2;
        const f32x4 a2g = first ? z : *(const f32x4*)(hp + 2 * FF2 + cg), a2v = first ? z : *(const f32x4*)(hp + 2 * FF2 + cv);
        const f32x4 a1g = first ? z : *(const f32x4*)(hp + 3 * FF2 + cg), a1v = first ? z : *(const f32x4*)(hp + 3 * FF2 + cv);
        const f32x4 r0g = *(const f32x4*)(hc_ + cg), r0v = *(const f32x4*)(hc_ + cv), r1g = *(const f32x4*)(hc_ + FF2 + cg), r1v = *(const f32x4*)(hc_ + FF2 + cv);
        const f32x4 w0g = *(const f32x4*)(cw + cg), w1g = *(const f32x4*)(cw + FF2 + cg), w2g = *(const f32x4*)(cw + 2 * FF2 + cg), bg = *(const f32x4*)(cb + cg);
        const f32x4 w0v = *(const f32x4*)(cw + cv), w1v = *(const f32x4*)(cw + FF2 + cv), w2v = *(const f32x4*)(cw + 2 * FF2 + cv), bv = *(const f32x4*)(cb + cv);
#pragma unroll
        for (int r = 0; r < 2; ++r) {
            const f32x4 hcg = bg + w0g * (r == 0 ? a2g : a1g) + w1g * (r == 0 ? a1g : r0g) + w2g * (r == 0 ? r0g : r1g);
            const f32x4 hcv = bv + w0v * (r == 0 ? a2v : a1v) + w1v * (r == 0 ? a1v : r0v) + w2v * (r == 0 ? r0v : r1v);
            const f32x2 ga = gelu_pk((f32x2){hcg[0], hcg[1]}), gb2 = gelu_pk((f32x2){hcg[2], hcg[3]});
            u32x2 w; w.x = cvt_pk_bf16(ga.x * hcv[0], ga.y * hcv[1]); w.y = cvt_pk_bf16(gb2.x * hcv[2], gb2.y * hcv[3]);
            *(u32x2*)(U + (size_t)(pm * 256 + r) * FF + cg) = w;
        }
        }
    }
}

template <int NB, int UN>
__device__ __forceinline__ void small_mma(f32x4 (&acc)[NB], const bf16_t* ap, const bf16_t* const (&bp)[NB], int K) {
#pragma unroll 1
    for (int k0 = 0; k0 < K; k0 += 32 * UN) {
        bf16x8 a[UN], b[NB][UN];
#pragma unroll
        for (int u = 0; u < UN; ++u) { a[u] = *(const bf16x8*)(ap + k0 + 32 * u);
#pragma unroll
            for (int nb = 0; nb < NB; ++nb) b[nb][u] = *(const bf16x8*)(bp[nb] + k0 + 32 * u); }
#pragma unroll
        for (int u = 0; u < UN; ++u)
#pragma unroll
            for (int nb = 0; nb < NB; ++nb) acc[nb] = __builtin_amdgcn_mfma_f32_16x16x32_bf16(b[nb][u], a[u], acc[nb], 0, 0, 0);
    }
}
struct SmallId { int w, fr, fq, row; };
__device__ __forceinline__ SmallId small_id() { int tid = threadIdx.x; asm volatile("" : "+v"(tid)); SmallId i; i.w = __builtin_amdgcn_readfirstlane(tid >> 6); i.fr = tid & 15; i.fq = (tid & 63) >> 4; i.row = MP + 16 * i.w + i.fr; return i; }


template <int KSTEPS  >
__device__ __forceinline__ void small_mma_ksplit(f32x4 (&acc)[2], const bf16_t* A, int lda, const bf16_t* Bt, int ldb, int n0, LAS unsigned char* lds, const SmallId& id) {
    const int lane = id.fq * 16 + id.fr, k0 = id.w * (KSTEPS * 32);
    f32x4 part[8][2];
#pragma unroll
    for (int rb = 0; rb < 8; ++rb) { part[rb][0] = (f32x4){0.f, 0.f, 0.f, 0.f}; part[rb][1] = part[rb][0]; }
    const bf16_t* ap = A + (size_t)(MP + id.fr) * lda + k0 + 8 * id.fq;
    const bf16_t* bp = Bt + (size_t)(n0 + id.fr) * ldb + k0 + 8 * id.fq;
#pragma unroll 1
    for (int ks = 0; ks < KSTEPS; ++ks) {
        bf16x8 a[8], b[2];
#pragma unroll
        for (int rb = 0; rb < 8; ++rb) a[rb] = *(const bf16x8*)(ap + (size_t)(16 * rb) * lda + 32 * ks);
        b[0] = *(const bf16x8*)(bp + 32 * ks); b[1] = *(const bf16x8*)(bp + (size_t)16 * ldb + 32 * ks);
#pragma unroll
        for (int rb = 0; rb < 8; ++rb) { part[rb][0] = __builtin_amdgcn_mfma_f32_16x16x32_bf16(b[0], a[rb], part[rb][0], 0, 0, 0); part[rb][1] = __builtin_amdgcn_mfma_f32_16x16x32_bf16(b[1], a[rb], part[rb][1], 0, 0, 0); }
    }
    LAS f32x4* red = (LAS f32x4*)lds;
#pragma unroll
    for (int rb = 0; rb < 8; ++rb) { red[((id.w * 8 + rb) * 2 + 0) * 64 + lane] = part[rb][0]; red[((id.w * 8 + rb) * 2 + 1) * 64 + lane] = part[rb][1]; }
    asm volatile("s_waitcnt lgkmcnt(0)" ::: "memory"); __syncthreads();
    acc[0] = (f32x4){0.f, 0.f, 0.f, 0.f}; acc[1] = acc[0];
#pragma unroll
    for (int w2 = 0; w2 < 8; ++w2) { acc[0] += red[((w2 * 8 + id.w) * 2 + 0) * 64 + lane]; acc[1] += red[((w2 * 8 + id.w) * 2 + 1) * 64 + lane]; }
    asm volatile("s_waitcnt lgkmcnt(0)" ::: "memory"); __syncthreads();
}

__device__ __forceinline__ void small_proj(const Params& p, int l, int G, int bx) {
    const SmallId id = small_id();
    const bf16_t* XB = (const bf16_t*)(p.ws + WS_XB); const bf16_t* Bt = (const bf16_t*)(p.ws + WS_W + (size_t)l * W_LAYER + WO_IN); bf16_t* PROJ = (bf16_t*)(p.ws + WS_PROJ);
    const float* ssq = (const float*)(p.ws + WS_SSQ) + (2 * l) * MPAD; const float* gb = p.gate_bias + l * 2048;
    for (int ts = G - 1 - bx; ts < INW / 32; ts += G) {
        const int n0 = ts * 32; f32x4 acc[2] = {(f32x4){0.f, 0.f, 0.f, 0.f}, (f32x4){0.f, 0.f, 0.f, 0.f}};
        const bf16_t* ap = XB + (size_t)id.row * DM + 8 * id.fq;
        const bf16_t* const bp[2] = {Bt + (size_t)(n0 + id.fr) * DM + 8 * id.fq, Bt + (size_t)(n0 + 16 + id.fr) * DM + 8 * id.fq};
        small_mma<2, 8>(acc, ap, bp, DM);
        const float rs = __builtin_amdgcn_rsqf(ssq[id.row] * (1.0f / 1024.0f) + EPS);
#pragma unroll
        for (int nb = 0; nb < 2; ++nb) { const int col = n0 + 16 * nb + 4 * id.fq; float v[4];
#pragma unroll
            for (int j = 0; j < 4; ++j) { float x = acc[nb][j] * rs; if (n0 >= 1280) { x += gb[col - 1280 + j]; x = __builtin_amdgcn_rcpf(1.0f + __builtin_amdgcn_exp2f(-LOG2E * x)); } v[j] = x; }
            u32x2 w; w.x = cvt_pk_bf16(v[0], v[1]); w.y = cvt_pk_bf16(v[2], v[3]); *(u32x2*)(PROJ + (size_t)id.row * INW + col) = w; }
    }
}
__device__ __forceinline__ void small_mix(const Params& p, int l, LAS unsigned char* lds, int G, int bx) {
    const SmallId id = small_id();
    const bf16_t* AD = (const bf16_t*)(p.ws + WS_AD); const bf16_t* Bm = (const bf16_t*)(p.ws + WS_W + (size_t)l * W_LAYER + WO_MIX); const bf16_t* PROJ = (const bf16_t*)(p.ws + WS_PROJ); bf16_t* MIX = (bf16_t*)(p.ws + WS_MIX);
    for (int ts = G - 1 - bx; ts < DM / 32; ts += G) {
        const int n0 = ts * 32; f32x4 ya[2] = {(f32x4){0.f, 0.f, 0.f, 0.f}, (f32x4){0.f, 0.f, 0.f, 0.f}}, yb[2] = {(f32x4){0.f, 0.f, 0.f, 0.f}, (f32x4){0.f, 0.f, 0.f, 0.f}};
        small_mma_ksplit<2>(ya, AD, DM, Bm, 512, n0, lds, id);
        small_mma_ksplit<2>(yb, AD + 512, DM, Bm + (size_t)1024 * 512, 512, n0, lds, id);
#pragma unroll
        for (int nb = 0; nb < 2; ++nb) { const int col = n0 + 16 * nb + 4 * id.fq;
            const u32x2 g0 = *(const u32x2*)(PROJ + (size_t)id.row * INW + 1280 + col), g1 = *(const u32x2*)(PROJ + (size_t)id.row * INW + 2304 + col);
            const float v0 = bf_lo(g0.x) * ya[nb][0] + bf_lo(g1.x) * yb[nb][0], v1 = bf_hi(g0.x) * ya[nb][1] + bf_hi(g1.x) * yb[nb][1];
            const float v2 = bf_lo(g0.y) * ya[nb][2] + bf_lo(g1.y) * yb[nb][2], v3 = bf_hi(g0.y) * ya[nb][3] + bf_hi(g1.y) * yb[nb][3];
            u32x2 w; w.x = cvt_pk_bf16(v0, v1); w.y = cvt_pk_bf16(v2, v3); *(u32x2*)(MIX + (size_t)id.row * DM + col) = w; }
    }
}
template <bool RES_F32, bool OUT_F32, int KSTEPS>
__device__ __forceinline__ void small_res(const Params& p, LAS unsigned char* lds, const bf16_t* A, int lda, const bf16_t* Bt, int K, float* ssq_next, int G, int bx) {
    const SmallId id = small_id();
    bf16_t* XB = (bf16_t*)(p.ws + WS_XB);
    for (int ts = G - 1 - bx; ts < DM / 32; ts += G) {
        const int n0 = ts * 32; f32x4 acc[2] = {(f32x4){0.f, 0.f, 0.f, 0.f}, (f32x4){0.f, 0.f, 0.f, 0.f}};
        small_mma_ksplit<KSTEPS>(acc, A, lda, Bt, K, n0, lds, id);
        float s = 0.f;
#pragma unroll
        for (int nb = 0; nb < 2; ++nb) { const int col = n0 + 16 * nb + 4 * id.fq;
            f32x4 r;
            if (RES_F32) r = *(const f32x4*)(p.xs + (size_t)(id.row - MP) * DM + col);
            else { const u32x2 w = *(const u32x2*)(XB + (size_t)id.row * DM + col); r = (f32x4){bf_lo(w.x), bf_hi(w.x), bf_lo(w.y), bf_hi(w.y)}; }
            const f32x4 x = r + acc[nb];
            if (OUT_F32) *(f32x4*)(p.out + (size_t)id.row * DM + col) = x;
            else { u32x2 w; w.x = cvt_pk_bf16(x[0], x[1]); w.y = cvt_pk_bf16(x[2], x[3]); *(u32x2*)(XB + (size_t)id.row * DM + col) = w; }
            s += (x[0] * x[0] + x[1] * x[1]) + (x[2] * x[2] + x[3] * x[3]); }
        if (!OUT_F32) { s += __shfl_xor(s, 16); s += __shfl_xor(s, 32); if (id.fq == 0) atomicAdd(ssq_next + id.row, s); }
    }
}
__device__ __forceinline__ void small_up(const Params& p, int l, LAS unsigned char* lds, int G, int bx) {
    const SmallId id = small_id();
    const bf16_t* XB = (const bf16_t*)(p.ws + WS_XB); const bf16_t* Bu = (const bf16_t*)(p.ws + WS_W + (size_t)l * W_LAYER + WO_UP); bf16_t* U = (bf16_t*)(p.ws + WS_PROJ);
    const float* ssq = (const float*)(p.ws + WS_SSQ) + (2 * l + 1) * MPAD;
    const float* cw = p.conv_w + (size_t)l * 3 * FF2; const float* cb = p.conv_b + (size_t)l * FF2; const float* sconv = p.state_conv + (size_t)l * 8 * 2 * FF2; float* conv_s = p.out + O_CS + (size_t)l * 8 * 2 * FF2;
    for (int ts = G - 1 - bx; ts < FF / 32; ts += G) {
        const int c0 = ts * 32; f32x4 acc[4];
        const int rb0 = (c0 >> 7) * 256 + (c0 & 127);
        { f32x4 ag[2], av[2];
          small_mma_ksplit<4>(ag, XB, DM, Bu, DM, rb0, lds, id);
          small_mma_ksplit<4>(av, XB, DM, Bu, DM, rb0 + 128, lds, id);
          acc[0] = ag[0]; acc[1] = ag[1]; acc[2] = av[0]; acc[3] = av[1]; }
        const float rs = __builtin_amdgcn_rsqf(ssq[id.row] * (1.0f / 1024.0f) + EPS);
        const int fr = id.fr;
#pragma unroll
        for (int nb = 0; nb < 2; ++nb) {
            const int colg = c0 + 16 * nb + 4 * id.fq, colv = FF + colg;
            const f32x4 cg_ = acc[nb] * rs, cv_ = acc[2 + nb] * rs;
            f32x4 hg = (f32x4){0.f, 0.f, 0.f, 0.f}, hv = hg;
            if (fr >= 14) { const float* sp = sconv + (size_t)(id.w * 2 + (fr - 14)) * FF2; hg = *(const f32x4*)(sp + colg); hv = *(const f32x4*)(sp + colv); }
            const f32x4 w0g = *(const f32x4*)(cw + colg), w1g = *(const f32x4*)(cw + FF2 + colg), w2g = *(const f32x4*)(cw + 2 * FF2 + colg), bg = *(const f32x4*)(cb + colg);
            const f32x4 w0v = *(const f32x4*)(cw + colv), w1v = *(const f32x4*)(cw + FF2 + colv), w2v = *(const f32x4*)(cw + 2 * FF2 + colv), bv = *(const f32x4*)(cb + colv);
            f32x4 p1g, p2g, p1v, p2v;
#pragma unroll
            for (int j = 0; j < 4; ++j) {
                p1g[j] = ror1(fr == 15 ? hg[j] : cg_[j]); p2g[j] = ror2(fr >= 14 ? hg[j] : cg_[j]);
                p1v[j] = ror1(fr == 15 ? hv[j] : cv_[j]); p2v[j] = ror2(fr >= 14 ? hv[j] : cv_[j]);
            }
            const f32x4 hcg = bg + w0g * p2g + w1g * p1g + w2g * cg_;
            const f32x4 hcv = bv + w0v * p2v + w1v * p1v + w2v * cv_;
            const f32x2 ga = gelu_pk((f32x2){hcg[0], hcg[1]}), gb2 = gelu_pk((f32x2){hcg[2], hcg[3]});
            u32x2 w; w.x = cvt_pk_bf16(ga.x * hcv[0], ga.y * hcv[1]); w.y = cvt_pk_bf16(gb2.x * hcv[2], gb2.y * hcv[3]);
            *(u32x2*)(U + (size_t)id.row * FF + colg) = w;
            if (fr >= 14) { float* cp = conv_s + (size_t)(id.w * 2 + (fr - 14)) * FF2; *(f32x4*)(cp + colg) = cg_; *(f32x4*)(cp + colv) = cv_; }
        }
    }
}

__device__ __forceinline__ int crow(int r, int hi) { return (r & 3) + 8 * (r >> 2) + 4 * hi; }
constexpr int KS_LD = 72, VT_LD = 200, LDS_VT = 192 * KS_LD * 2, LDS_WSC = LDS_VT + 64 * VT_LD * 2, LDS_OST = LDS_WSC + 1024;


template <int W>
__device__ __forceinline__ void pool_items(const Params& p, int l, bool sample, int b, int c, int g, long row0, int tid) {
    const bf16_t* P = (const bf16_t*)(p.ws + WS_PROJ);
    bf16_t* AD = (bf16_t*)(p.ws + WS_AD);
    const int nitems = sample ? 16 * 16 : 64 * 16;
#pragma unroll 1
    for (int it = tid; it < nitems; it += 512) {
        const int tl = it >> 4, ch = it & 15, col = g * 128 + ch * 8;
        const long prow = row0 + tl; const int t = sample ? tl : c * 64 + tl;
        u32x4 raw[W]; f32x4 h0[W], h1[W];
#pragma unroll
        for (int i = 0; i < W; ++i) {
            const int tt = t - i;
            raw[i] = (u32x4){0u, 0u, 0u, 0u}; h0[i] = (f32x4){0.f, 0.f, 0.f, 0.f}; h1[i] = h0[i];
            if (tt >= 0) raw[i] = *(const u32x4*)(P + (size_t)(prow - i) * INW + 768 + col);
            else if (sample) { const float* sp = p.state_pool + (((size_t)l * 8 + b) * 15 + (15 + tt)) * 512 + col; h0[i] = *(const f32x4*)sp; h1[i] = *(const f32x4*)(sp + 4); }
        }
        float cur[8], a[8];
        unpack8(raw[0], cur);
#pragma unroll
        for (int k = 0; k < 8; ++k) a[k] = cur[k];
#pragma unroll
        for (int i = 1; i < W; ++i) { float x[8]; unpack8(raw[i], x);
#pragma unroll
            for (int k = 0; k < 4; ++k) { a[k] += x[k] + h0[i][k]; a[4 + k] += x[4 + k] + h1[i][k]; } }
        const float cnt = sample ? (float)W : (float)((t + 1) < W ? (t + 1) : W);
        const float inv = 1.0f / cnt;
        float d[8];
#pragma unroll
        for (int k = 0; k < 8; ++k) d[k] = a[k] * inv - cur[k];
        *(u32x4*)(AD + (size_t)prow * DM + 512 + col) = pack8(d);
        float* pd = nullptr;
        if (!sample) { if (t >= SEQ - 15) pd = p.out + O_PP + (((size_t)l * 2 + b) * 15 + (t - (SEQ - 15))) * 512 + col; }
        else if (tl >= 1) pd = p.out + O_PS + (((size_t)l * 8 + b) * 15 + (tl - 1)) * 512 + col;
        if (pd) { *(f32x4*)pd = (f32x4){cur[0], cur[1], cur[2], cur[3]}; *(f32x4*)(pd + 4) = (f32x4){cur[4], cur[5], cur[6], cur[7]}; }
    }
}

template <int W>
__device__ __forceinline__ void pool_task_prompt(const Params& p, int l, int b, int c, int g, int rg, int ch, long row0) {
    const bf16_t* P = (const bf16_t*)(p.ws + WS_PROJ);
    bf16_t* AD = (bf16_t*)(p.ws + WS_AD);
    const int col = g * 128 + ch * 8, tl0 = 4 * rg, t0 = c * 64 + tl0;
    u32x4 raw[W + 3];
#pragma unroll
    for (int i = 0; i < W + 3; ++i) { const int tt = t0 - (W - 1) + i; raw[i] = (u32x4){0u, 0u, 0u, 0u};
        if (tt >= 0) raw[i] = *(const u32x4*)(P + (size_t)((long)b * SEQ + tt) * INW + 768 + col); }
    float a[4][8], cur[4][8];
#pragma unroll
    for (int k = 0; k < 8; ++k) a[0][k] = 0.f;
#pragma unroll
    for (int i = 0; i < W; ++i) { float x[8]; unpack8(raw[i], x);
#pragma unroll
        for (int k = 0; k < 8; ++k) { a[0][k] += x[k]; if (i == W - 1) cur[0][k] = x[k]; } }
#pragma unroll
    for (int r = 1; r < 4; ++r) { float xin[8], xout[8]; unpack8(raw[W - 1 + r], xin); unpack8(raw[r - 1], xout);
#pragma unroll
        for (int k = 0; k < 8; ++k) { a[r][k] = a[r - 1][k] + (xin[k] - xout[k]); cur[r][k] = xin[k]; } }
#pragma unroll
    for (int r = 0; r < 4; ++r) {
        const int t = t0 + r;
        const float inv = 1.0f / (float)((t + 1) < W ? (t + 1) : W);
        float d[8];
#pragma unroll
        for (int k = 0; k < 8; ++k) d[k] = a[r][k] * inv - cur[r][k];
        *(u32x4*)(AD + (size_t)(row0 + tl0 + r) * DM + 512 + col) = pack8(d);
        if (t >= SEQ - 15) { float* pd = p.out + O_PP + (((size_t)l * 2 + b) * 15 + (t - (SEQ - 15))) * 512 + col;
            *(f32x4*)pd = (f32x4){cur[r][0], cur[r][1], cur[r][2], cur[r][3]}; *(f32x4*)(pd + 4) = (f32x4){cur[r][4], cur[r][5], cur[r][6], cur[r][7]}; }
    }
}

__device__ __forceinline__ void attn_unit(const Params& p, int l, LAS unsigned char* lds, bool sample, int b, int c, int kvh) {
    int tid = threadIdx.x; asm volatile("" : "+v"(tid));
    const int wid = __builtin_amdgcn_readfirstlane(tid >> 6);
    int lane = tid & 63; asm volatile("" : "+v"(lane));
    const int q32 = lane & 31, hi = lane >> 5;
    LAS bf16_t* Ks = (LAS bf16_t*)lds; LAS bf16_t* Vt = (LAS bf16_t*)(lds + LDS_VT); LAS float* wsc = (LAS float*)(lds + LDS_WSC) + wid * 32;
    const bf16_t* P = (const bf16_t*)(p.ws + WS_PROJ);
    bf16_t* AD = (bf16_t*)(p.ws + WS_AD);
    const long row0 = sample ? (long)MP + b * 16 : (long)b * SEQ + c * 64;
    if (sample) {
#pragma unroll
        for (int gl = 0; gl < 2; ++gl) {
            const int g = kvh * 2 + gl;
            if (g == 0) pool_items<2>(p, l, sample, b, c, g, row0, tid);
            else if (g == 1) pool_items<4>(p, l, sample, b, c, g, row0, tid);
            else if (g == 2) pool_items<8>(p, l, sample, b, c, g, row0, tid);
            else pool_items<16>(p, l, sample, b, c, g, row0, tid);
        }
        __builtin_amdgcn_sched_barrier(0);
    }
    const int gq = wid >> 1, half = wid & 1, h = kvh * 4 + gq;
    const bool active = !sample || half == 0;
    const int tq = half * 32 + q32;
    const long qrow = sample ? row0 + (q32 & 15) : row0 + tq;
    u32x4 qraw[4];
#pragma unroll
    for (int d0 = 0; d0 < 4; ++d0) qraw[d0] = *(const u32x4*)(P + (size_t)qrow * INW + h * 64 + d0 * 16 + hi * 8);
    u32x4 kraw[3], vraw[3]; f32x4 kc0[3], kc1[3], vc0[3], vc1[3];
#pragma unroll
    for (int it = 0; it < 3; ++it) {
        const int idx = it * 512 + tid, j = idx >> 3, ch = idx & 7;
        kraw[it] = (u32x4){0u, 0u, 0u, 0u}; vraw[it] = kraw[it];
        kc0[it] = (f32x4){0.f, 0.f, 0.f, 0.f}; kc1[it] = kc0[it]; vc0[it] = kc0[it]; vc1[it] = kc0[it];
        if (!sample) { const int tk = c * 64 - 128 + j;
            if (tk >= 0) { const size_t o = (size_t)((long)b * SEQ + tk) * INW + kvh * 64 + ch * 8; kraw[it] = *(const u32x4*)(P + o + 512); vraw[it] = *(const u32x4*)(P + o + 640); } }
        else if (j < 128) { const size_t ci = ((((size_t)l * 8 + b) * 128 + j) * 2 + kvh) * 64 + ch * 8;
            kc0[it] = *(const f32x4*)(p.cache_k + ci); kc1[it] = *(const f32x4*)(p.cache_k + ci + 4); vc0[it] = *(const f32x4*)(p.cache_v + ci); vc1[it] = *(const f32x4*)(p.cache_v + ci + 4); }
        else if (j < 144) { const size_t o = (size_t)((long)MP + b * 16 + (j - 128)) * INW + kvh * 64 + ch * 8; kraw[it] = *(const u32x4*)(P + o + 512); vraw[it] = *(const u32x4*)(P + o + 640); }
    }
    if (!sample) {
        const int gl = tid >> 8, g = kvh * 2 + gl, rg = (tid >> 4) & 15, ch = tid & 15;
        if (g == 0) pool_task_prompt<2>(p, l, b, c, g, rg, ch, row0);
        else if (g == 1) pool_task_prompt<4>(p, l, b, c, g, rg, ch, row0);
        else if (g == 2) pool_task_prompt<8>(p, l, b, c, g, rg, ch, row0);
        else pool_task_prompt<16>(p, l, b, c, g, rg, ch, row0);
    }
    const float* knorm = p.k_norm + l * 64;
#pragma unroll
    for (int it = 0; it < 3; ++it) {
        const int idx = it * 512 + tid, j = idx >> 3, ch = idx & 7;
        float kf[8], vf[8];
        const bool fromproj = !sample || j >= 128;
        if (fromproj) { unpack8(kraw[it], kf); unpack8(vraw[it], vf); }
        else {
#pragma unroll
            for (int i = 0; i < 4; ++i) { kf[i] = kc0[it][i]; kf[4 + i] = kc1[it][i]; vf[i] = vc0[it][i]; vf[4 + i] = vc1[it][i]; } }
        float ss = 0.f;
#pragma unroll
        for (int i = 0; i < 8; ++i) ss += kf[i] * kf[i];
        ss += __shfl_xor(ss, 1); ss += __shfl_xor(ss, 2); ss += __shfl_xor(ss, 4);
        if (fromproj) { const float sc = __builtin_amdgcn_rsqf(ss * (1.0f / 64.0f) + EPS);
#pragma unroll
            for (int i = 0; i < 8; ++i) kf[i] = kf[i] * sc * knorm[ch * 8 + i]; }
        *(LAS u32x4*)(Ks + j * KS_LD + ch * 8) = pack8(kf);
#pragma unroll
        for (int i = 0; i < 8; i += 2) { const unsigned w = cvt_pk_bf16(vf[i], vf[i + 1]); const int js = j ^ (ch << 3);
            Vt[(ch * 8 + i) * VT_LD + js] = (bf16_t)(w & 0xffffu); Vt[(ch * 8 + i + 1) * VT_LD + js] = (bf16_t)(w >> 16); }
        float* kd = nullptr; float* vd = nullptr;
        if (!sample) { if (c >= 254 && j >= 128) { const size_t o = ((((size_t)l * 2 + b) * 128 + (c - 254) * 64 + (j - 128)) * 2 + kvh) * 64 + ch * 8; kd = p.out + O_KP + o; vd = p.out + O_VP + o; } }
        else if (j >= 16 && j < 144) { const size_t o = ((((size_t)l * 8 + b) * 128 + (j - 16)) * 2 + kvh) * 64 + ch * 8; kd = p.out + O_KS + o; vd = p.out + O_VS + o; }
        if (kd) { *(f32x4*)kd = (f32x4){kf[0], kf[1], kf[2], kf[3]}; *(f32x4*)(kd + 4) = (f32x4){kf[4], kf[5], kf[6], kf[7]};
                  *(f32x4*)vd = (f32x4){vf[0], vf[1], vf[2], vf[3]}; *(f32x4*)(vd + 4) = (f32x4){vf[4], vf[5], vf[6], vf[7]}; }
    }
    bf16x8 qf[4];
    {
        float qv[4][8]; float ss = 0.f;
#pragma unroll
        for (int d0 = 0; d0 < 4; ++d0) { unpack8(qraw[d0], qv[d0]);
#pragma unroll
            for (int i = 0; i < 8; ++i) ss += qv[d0][i] * qv[d0][i]; }
        ss += __shfl_xor(ss, 32);
        const float sc = __builtin_amdgcn_rsqf(ss * (1.0f / 64.0f) + EPS) * (0.125f * LOG2E);
        const float* qn = p.q_norm + l * 64;
#pragma unroll
        for (int d0 = 0; d0 < 4; ++d0) { float t8[8];
#pragma unroll
            for (int i = 0; i < 8; ++i) t8[i] = qv[d0][i] * sc * qn[d0 * 16 + hi * 8 + i];
            qf[d0] = __builtin_bit_cast(bf16x8, pack8(t8)); }
    }
    __syncthreads();
    if (active) {
        f32x16 s[6];
#pragma unroll
        for (int kt = 0; kt < 6; ++kt) {
            s[kt] = (f32x16){};
#pragma unroll
            for (int d0 = 0; d0 < 4; ++d0) {
                const bf16x8 kfr = *(const LAS bf16x8*)(Ks + (kt * 32 + q32) * KS_LD + d0 * 16 + hi * 8);
                s[kt] = __builtin_amdgcn_mfma_f32_32x32x16_bf16(kfr, qf[d0], s[kt], 0, 0, 0);
            }
        }
        const float slope2 = __builtin_amdgcn_exp2f(-(float)(h + 1)) * LOG2E;
        const int jmin = sample ? 0 : (c >= 2 ? 0 : 128 - 64 * c), jmax = sample ? 144 : 192;
        float mx = -3.0e38f;
        const float relb = (float)(128 + tq - 4 * hi);
        const bool need_mask = sample || c < 2;
#pragma unroll
        for (int kt = 0; kt < 6; ++kt)
#pragma unroll
            for (int r = 0; r < 16; ++r) {
                float v = __builtin_fmaf(-slope2, __builtin_fabsf(relb - (float)(32 * kt + (r & 3) + 8 * (r >> 2))), s[kt][r]);
                if (need_mask) { const int j = 32 * kt + crow(r, hi); if (j < jmin || j >= jmax) v = -1.0e30f; }
                s[kt][r] = v; mx = __builtin_fmaxf(mx, v);
            }
        mx = __builtin_fmaxf(mx, __shfl_xor(mx, 32));
        const float sink2 = p.sinks[l * 8 + h] * LOG2E;
        const float mm = __builtin_fmaxf(mx, sink2);
        float sum = 0.f;
#pragma unroll
        for (int kt = 0; kt < 6; ++kt)
#pragma unroll
            for (int r = 0; r < 16; ++r) { const float e = __builtin_amdgcn_exp2f(s[kt][r] - mm); s[kt][r] = e; sum += e; }
        sum += __shfl_xor(sum, 32);
        const float denom = sum + __builtin_amdgcn_exp2f(sink2 - mm);
        if (hi == 0) wsc[q32] = 1.0f / denom;
        f32x16 o[2]; o[0] = (f32x16){}; o[1] = (f32x16){};
#pragma unroll
        for (int kt = 0; kt < 6; ++kt)
#pragma unroll
            for (int jj = 0; jj < 2; ++jj) {
                u32x4 pw;
                pw.x = cvt_pk_bf16(s[kt][8 * jj + 0], s[kt][8 * jj + 1]); pw.y = cvt_pk_bf16(s[kt][8 * jj + 2], s[kt][8 * jj + 3]);
                pw.z = cvt_pk_bf16(s[kt][8 * jj + 4], s[kt][8 * jj + 5]); pw.w = cvt_pk_bf16(s[kt][8 * jj + 6], s[kt][8 * jj + 7]);
                const bf16x8 pa = __builtin_bit_cast(bf16x8, pw);
                const int e0 = 32 * kt + 16 * jj + 4 * hi;
#pragma unroll
                for (int db = 0; db < 2; ++db) {
                    const int sw = (((db * 32 + q32) >> 3) & 7) << 3;
                    const u32x2 lo = *(const LAS u32x2*)(Vt + (db * 32 + q32) * VT_LD + (e0 ^ sw)), hi2 = *(const LAS u32x2*)(Vt + (db * 32 + q32) * VT_LD + ((e0 + 8) ^ sw));
                    const bf16x8 vb = __builtin_bit_cast(bf16x8, (u32x4){lo.x, lo.y, hi2.x, hi2.y});
                    o[db] = __builtin_amdgcn_mfma_f32_32x32x16_bf16(pa, vb, o[db], 0, 0, 0);
                }
                __builtin_amdgcn_sched_barrier(0);
            }
        asm volatile("s_waitcnt lgkmcnt(0)" ::: "memory");
        LAS bf16_t* ost = (LAS bf16_t*)(lds + LDS_OST) + wid * (32 * 72);
#pragma unroll
        for (int r = 0; r < 16; ++r) {
            const int qq = crow(r, hi);
            const float inv = wsc[qq];
#pragma unroll
            for (int db = 0; db < 2; ++db) ost[qq * 72 + db * 32 + q32] = (bf16_t)(cvt_pk_bf16(o[db][r] * inv, 0.f) & 0xffffu);
        }
        asm volatile("s_waitcnt lgkmcnt(0)" ::: "memory");
#pragma unroll
        for (int i = 0; i < 4; ++i) {
            const int row = i * 8 + (lane >> 3), chn = lane & 7;
            const u32x4 v = *(const LAS u32x4*)(ost + row * 72 + chn * 8);
            if (!sample || row < 16) { const long orow = sample ? row0 + row : row0 + half * 32 + row; *(u32x4*)(AD + (size_t)orow * DM + h * 64 + chn * 8) = v; }
        }
    }
    __syncthreads();
}


constexpr int MK_LD = 72, MV_LD = 392, M_VT = 384 * MK_LD * 2, M_WSC = M_VT + 64 * MV_LD * 2, M_OST = M_WSC + 1024;
static_assert(M_OST + 8 * 32 * 72 * 2 <= MISC_OFF, "attention macro-unit LDS map");
__device__ __forceinline__ void attn_macro(const Params& p, int l, LAS unsigned char* lds, int b, int cg, int kvh) {
    int tid = threadIdx.x; asm volatile("" : "+v"(tid));
    const int wid = __builtin_amdgcn_readfirstlane(tid >> 6);
    int lane = tid & 63; asm volatile("" : "+v"(lane));
    const int q32 = lane & 31, hi = lane >> 5;
    LAS bf16_t* Ks = (LAS bf16_t*)lds; LAS bf16_t* Vt = (LAS bf16_t*)(lds + M_VT); LAS float* wsc = (LAS float*)(lds + M_WSC) + wid * 32;
    const bf16_t* P = (const bf16_t*)(p.ws + WS_PROJ);
    bf16_t* AD = (bf16_t*)(p.ws + WS_AD);
    const int c0 = 4 * cg;
    const long rowb = (long)b * SEQ;
    const int gq = wid >> 1, half = wid & 1, h = kvh * 4 + gq, tq = half * 32 + q32;
    u32x4 qraw[4];
#pragma unroll
    for (int i = 0; i < 4; ++i) qraw[i] = *(const u32x4*)(P + (size_t)(rowb + c0 * 64 + half * 32 + i * 8 + (lane >> 3)) * INW + h * 64 + (lane & 7) * 8);
    u32x4 kraw[6], vraw[6];
#pragma unroll
    for (int it = 0; it < 6; ++it) {
        const int idx = it * 512 + tid, j = idx >> 3, ch = idx & 7, tk = c0 * 64 - 128 + j;
        kraw[it] = (u32x4){0u, 0u, 0u, 0u}; vraw[it] = kraw[it];
        if (tk >= 0) { const size_t o = (size_t)(rowb + tk) * INW + kvh * 64 + ch * 8; kraw[it] = *(const u32x4*)(P + o + 512); vraw[it] = *(const u32x4*)(P + o + 640); }
    }
    const float* knorm = p.k_norm + l * 64;
#pragma unroll
    for (int it = 0; it < 6; ++it) {
        const int idx = it * 512 + tid, j = idx >> 3, ch = idx & 7;
        float kf[8], vf[8]; unpack8(kraw[it], kf); unpack8(vraw[it], vf);
        float ss = 0.f;
#pragma unroll
        for (int i = 0; i < 8; ++i) ss += kf[i] * kf[i];
        ss += __shfl_xor(ss, 1); ss += __shfl_xor(ss, 2); ss += __shfl_xor(ss, 4);
        const float sc = __builtin_amdgcn_rsqf(ss * (1.0f / 64.0f) + EPS);
#pragma unroll
        for (int i = 0; i < 8; ++i) kf[i] = kf[i] * sc * knorm[ch * 8 + i];
        *(LAS u32x4*)(Ks + j * MK_LD + ch * 8) = pack8(kf);
        const int js = j ^ (ch << 3);
#pragma unroll
        for (int i = 0; i < 8; i += 2) { const unsigned w = cvt_pk_bf16(vf[i], vf[i + 1]); Vt[(ch * 8 + i) * MV_LD + js] = (bf16_t)(w & 0xffffu); Vt[(ch * 8 + i + 1) * MV_LD + js] = (bf16_t)(w >> 16); }
        if (cg == 63 && j >= 256) {
            const size_t o = ((((size_t)l * 2 + b) * 128 + (j - 256)) * 2 + kvh) * 64 + ch * 8; float* kd = p.out + O_KP + o; float* vd = p.out + O_VP + o;
            *(f32x4*)kd = (f32x4){kf[0], kf[1], kf[2], kf[3]}; *(f32x4*)(kd + 4) = (f32x4){kf[4], kf[5], kf[6], kf[7]};
            *(f32x4*)vd = (f32x4){vf[0], vf[1], vf[2], vf[3]}; *(f32x4*)(vd + 4) = (f32x4){vf[4], vf[5], vf[6], vf[7]};
        }
    }
    __syncthreads();
    const float slope2 = __builtin_amdgcn_exp2f(-(float)(h + 1)) * LOG2E;
    const float sink2 = p.sinks[l * 8 + h] * LOG2E;
    const float* qn = p.q_norm + l * 64;
#pragma unroll 1
    for (int ci = 0; ci < 4; ++ci) {
        const int c = c0 + ci;
        const long row0 = rowb + (long)c * 64;
        int lane_ = lane; asm volatile("" : "+v"(lane_));
        const int q32 = lane_ & 31, hi = lane_ >> 5, tq = half * 32 + q32;
        const float relb = (float)(128 + tq - 4 * hi);
        bf16x8 qf[4];
        {
            LAS bf16_t* qst = (LAS bf16_t*)(lds + M_OST) + wid * (32 * 72);
#pragma unroll
            for (int i = 0; i < 4; ++i) *(LAS u32x4*)(qst + (i * 8 + (lane_ >> 3)) * 72 + (lane_ & 7) * 8) = qraw[i];
            asm volatile("s_waitcnt lgkmcnt(0)" ::: "memory");
            float qv[4][8]; float ss = 0.f;
#pragma unroll
            for (int d0 = 0; d0 < 4; ++d0) { unpack8(*(const LAS u32x4*)(qst + q32 * 72 + d0 * 16 + hi * 8), qv[d0]);
#pragma unroll
                for (int i = 0; i < 8; ++i) ss += qv[d0][i] * qv[d0][i]; }
            asm volatile("s_waitcnt lgkmcnt(0)" ::: "memory");
            ss += __shfl_xor(ss, 32);
            const float sc = __builtin_amdgcn_rsqf(ss * (1.0f / 64.0f) + EPS) * (0.125f * LOG2E);
#pragma unroll
            for (int d0 = 0; d0 < 4; ++d0) { float t8[8];
#pragma unroll
                for (int i = 0; i < 8; ++i) t8[i] = qv[d0][i] * sc * qn[d0 * 16 + hi * 8 + i];
                qf[d0] = __builtin_bit_cast(bf16x8, pack8(t8)); }
        }
        if (ci < 3) {
#pragma unroll
            for (int i = 0; i < 4; ++i) qraw[i] = *(const u32x4*)(P + (size_t)(row0 + 64 + half * 32 + i * 8 + (lane_ >> 3)) * INW + h * 64 + (lane_ & 7) * 8);
        }
        f32x16 s[6];
#pragma unroll
        for (int kt = 0; kt < 6; ++kt) {
            s[kt] = (f32x16){};
#pragma unroll
            for (int d0 = 0; d0 < 4; ++d0) {
                const bf16x8 kfr = *(const LAS bf16x8*)(Ks + (ci * 64 + kt * 32 + q32) * MK_LD + d0 * 16 + hi * 8);
                s[kt] = __builtin_amdgcn_mfma_f32_32x32x16_bf16(kfr, qf[d0], s[kt], 0, 0, 0);
            }
        }
        const int jmin = c >= 2 ? 0 : 128 - 64 * c;
        float mx = -3.0e38f;
#pragma unroll
        for (int kt = 0; kt < 6; ++kt)
#pragma unroll
            for (int r = 0; r < 16; ++r) {
                float v = __builtin_fmaf(-slope2, __builtin_fabsf(relb - (float)(32 * kt + (r & 3) + 8 * (r >> 2))), s[kt][r]);
                if (c < 2) { const int j = 32 * kt + crow(r, hi); if (j < jmin) v = -1.0e30f; }
                s[kt][r] = v; mx = __builtin_fmaxf(mx, v);
            }
        mx = __builtin_fmaxf(mx, __shfl_xor(mx, 32));
        const float mm = __builtin_fmaxf(mx, sink2);
        float sum = 0.f;
#pragma unroll
        for (int kt = 0; kt < 6; ++kt)
#pragma unroll
            for (int r = 0; r < 16; ++r) { const float e = __builtin_amdgcn_exp2f(s[kt][r] - mm); s[kt][r] = e; sum += e; }
        sum += __shfl_xor(sum, 32);
        const float denom = sum + __builtin_amdgcn_exp2f(sink2 - mm);
        if (hi == 0) wsc[q32] = 1.0f / denom;
        f32x16 o[2]; o[0] = (f32x16){}; o[1] = (f32x16){};
#pragma unroll
        for (int kt = 0; kt < 6; ++kt)
#pragma unroll
            for (int jj = 0; jj < 2; ++jj) {
                u32x4 pw;
                pw.x = cvt_pk_bf16(s[kt][8 * jj + 0], s[kt][8 * jj + 1]); pw.y = cvt_pk_bf16(s[kt][8 * jj + 2], s[kt][8 * jj + 3]);
                pw.z = cvt_pk_bf16(s[kt][8 * jj + 4], s[kt][8 * jj + 5]); pw.w = cvt_pk_bf16(s[kt][8 * jj + 6], s[kt][8 * jj + 7]);
                const bf16x8 pa = __builtin_bit_cast(bf16x8, pw);
                const int e0 = 32 * kt + 16 * jj + 4 * hi;
#pragma unroll
                for (int db = 0; db < 2; ++db) {
                    const int sw = (((db * 32 + q32) >> 3) & 7) << 3;
                    const LAS bf16_t* vrow = Vt + (db * 32 + q32) * MV_LD + ci * 64;
                    const u32x2 lo = *(const LAS u32x2*)(vrow + (e0 ^ sw)), hi2 = *(const LAS u32x2*)(vrow + ((e0 + 8) ^ sw));
                    const bf16x8 vb = __builtin_bit_cast(bf16x8, (u32x4){lo.x, lo.y, hi2.x, hi2.y});
                    o[db] = __builtin_amdgcn_mfma_f32_32x32x16_bf16(pa, vb, o[db], 0, 0, 0);
                }
                __builtin_amdgcn_sched_barrier(0);
            }
        asm volatile("s_waitcnt lgkmcnt(0)" ::: "memory");
        LAS bf16_t* ost = (LAS bf16_t*)(lds + M_OST) + wid * (32 * 72);
#pragma unroll
        for (int r = 0; r < 16; ++r) {
            const int qq = crow(r, hi);
            const float inv = wsc[qq];
#pragma unroll
            for (int db = 0; db < 2; ++db) ost[qq * 72 + db * 32 + q32] = (bf16_t)(cvt_pk_bf16(o[db][r] * inv, 0.f) & 0xffffu);
        }
        asm volatile("s_waitcnt lgkmcnt(0)" ::: "memory");
#pragma unroll
        for (int i = 0; i < 4; ++i) {
            const int row = i * 8 + (lane >> 3), chn = lane & 7;
            const u32x4 v = *(const LAS u32x4*)(ost + row * 72 + chn * 8);
            *(u32x4*)(AD + (size_t)(row0 + half * 32 + row) * DM + h * 64 + chn * 8) = v;
        }
        asm volatile("s_waitcnt lgkmcnt(0)" ::: "memory");
    }
    {
        const int gl = tid >> 8, g = kvh * 2 + gl, rg = (tid >> 4) & 15, ch = tid & 15;
#pragma unroll 1
        for (int ci = 0; ci < 4; ++ci) {
            const int c = c0 + ci; const long row0 = rowb + (long)c * 64;
            if (g == 0) pool_task_prompt<2>(p, l, b, c, g, rg, ch, row0);
            else if (g == 1) pool_task_prompt<4>(p, l, b, c, g, rg, ch, row0);
            else if (g == 2) pool_task_prompt<8>(p, l, b, c, g, rg, ch, row0);
            else pool_task_prompt<16>(p, l, b, c, g, rg, ch, row0);
        }
    }
    __syncthreads();
}

__device__ __forceinline__ float wave_sum(float v) {
#pragma unroll
    for (int o = 1; o < 64; o <<= 1) v += __shfl_xor(v, o);
    return v;
}
__device__ __forceinline__ void transpose_item(const float* W, int N, const float* ks, bf16_t* WT, int ldo, int orow0, int k0, int n0, LAS float* scr, int lane) {
    f32x4 v[8];
#pragma unroll
    for (int i = 0; i < 8; ++i) v[i] = *(const f32x4*)(W + (size_t)(k0 + i * 4 + (lane >> 4)) * N + n0 + 4 * (lane & 15));
#pragma unroll
    for (int i = 0; i < 8; ++i) { const int kk = i * 4 + (lane >> 4); const float sc = ks ? ks[k0 + kk] : 1.0f; LAS float* d = scr + kk * 65 + 4 * (lane & 15);
        d[0] = v[i][0] * sc; d[1] = v[i][1] * sc; d[2] = v[i][2] * sc; d[3] = v[i][3] * sc; }
    asm volatile("s_waitcnt lgkmcnt(0)" ::: "memory");
    const int kc = lane & 3;
#pragma unroll
    for (int j = 0; j < 4; ++j) { const int n = (lane >> 2) + 16 * j; const LAS float* s = scr + (8 * kc) * 65 + n;
        u32x4 o; o.x = cvt_pk_bf16(s[0 * 65], s[1 * 65]); o.y = cvt_pk_bf16(s[2 * 65], s[3 * 65]); o.z = cvt_pk_bf16(s[4 * 65], s[5 * 65]); o.w = cvt_pk_bf16(s[6 * 65], s[7 * 65]);
        *(u32x4*)(WT + (size_t)(orow0 + n) * ldo + k0 + 8 * kc) = o; }
    asm volatile("s_waitcnt lgkmcnt(0)" ::: "memory");
}

constexpr int WI_IN = 32 * 52, WI_BA = 16 * 16, WI_OUT = 32 * 16, WI_UP = 32 * 88, WI_DN = 88 * 16, WI_L = WI_IN + WI_BA + WI_OUT + WI_UP + WI_DN;
__device__ __forceinline__ void convert_weights(const Params& p, LAS unsigned char* lds, int first, int last, int worker, int nworkers) {
    int tid = threadIdx.x; asm volatile("" : "+v"(tid));
    const int lane = tid & 63, wid = __builtin_amdgcn_readfirstlane(tid >> 6);
    LAS float* scr = (LAS float*)(lds + wid * 16384);
#pragma unroll 1
    for (int it = first + worker; it < last; it += nworkers) {
        const int l = it / WI_L; int r = it % WI_L;
        unsigned char* wb = p.ws + WS_W + (size_t)l * W_LAYER;
        if (r < WI_IN) { const int kb = r / 52, nb = r % 52; transpose_item(p.w_in + (size_t)l * DM * INW, INW, p.norm_mix + l * DM, (bf16_t*)(wb + WO_IN), DM, nb * 64, kb * 32, nb * 64, scr, lane); continue; } r -= WI_IN;
        if (r < WI_BA) { const int kb = r / 16, nb = r % 16; transpose_item(p.w_br_attn + (size_t)l * 512 * DM, DM, nullptr, (bf16_t*)(wb + WO_MIX), 512, nb * 64, kb * 32, nb * 64, scr, lane); continue; } r -= WI_BA;
        if (r < WI_OUT) { const int kb = r / 16, nb = r % 16; transpose_item(p.w_out + (size_t)l * DM * DM, DM, nullptr, (bf16_t*)(wb + WO_OUT), DM, nb * 64, kb * 32, nb * 64, scr, lane); continue; } r -= WI_OUT;
        if (r < WI_UP) { const int kb = r / 88, nb = r % 88; const int n0 = nb * 64; const int nn = n0 < FF ? n0 : n0 - FF; const int orow = (nn >> 7) * 256 + (n0 < FF ? 0 : 128) + (nn & 127);
            transpose_item(p.w_up + (size_t)l * DM * FF2, FF2, p.norm_ffn + l * DM, (bf16_t*)(wb + WO_UP), DM, orow, kb * 32, n0, scr, lane); continue; } r -= WI_UP;
        { const int kb = r / 16, nb = r % 16; transpose_item(p.w_down + (size_t)l * FF * DM, DM, nullptr, (bf16_t*)(wb + WO_DOWN), FF, nb * 64, kb * 32, nb * 64, scr, lane); }
    }
}
__device__ __forceinline__ void convert_weights_idle(const Params& p, LAS unsigned char* lds, int first, int last, int nwg, int G, int bx) {
    int tid = threadIdx.x; asm volatile("" : "+v"(tid));
    const int rem = nwg % G, wid = __builtin_amdgcn_readfirstlane(tid >> 6);
    if (bx >= rem) convert_weights(p, lds, first, last, (bx - rem) * 8 + wid, (G - rem) * 8);
}
__device__ __forceinline__ void prologue(const Params& p, LAS unsigned char* lds) {
    const int tid = threadIdx.x, lane = tid & 63, wid = __builtin_amdgcn_readfirstlane(tid >> 6);
    const int gt = blockIdx.x * 512 + tid, NGT = gridDim.x * 512;
    float* ssq = (float*)(p.ws + WS_SSQ);
    for (int i = gt; i < 3 * MPAD; i += NGT) ssq[MPAD + i] = 0.f;
    {
        const int gwv = blockIdx.x * 8 + wid, NGWV = gridDim.x * 8;
        for (int it = gwv; it < 2 * 1024; it += NGWV) {
            const int l = it >> 10, r = it & 1023, nblk = r & 15, kg = r >> 4, g = kg >> 4, c0 = (kg & 15) * 8, n = nblk * 64 + lane;
            const float* wp = p.w_pool + ((size_t)l * 4 + g) * 128 * 128 + (size_t)c0 * 128;
            const float* sc = p.pool_scale + l * 512 + g * 128;
            const float* wb = p.w_br_pool + (size_t)l * 512 * DM + (size_t)(g * 128) * DM + n;
            float a[8];
#pragma unroll
            for (int i = 0; i < 8; ++i) a[i] = 0.f;
#pragma unroll 8
            for (int d = 0; d < 128; ++d) { const float x = wb[(size_t)d * DM] * sc[d];
#pragma unroll
                for (int i = 0; i < 8; ++i) a[i] += wp[i * 128 + d] * x; }
            bf16_t* dst = (bf16_t*)(p.ws + WS_W + (size_t)l * W_LAYER + WO_MIX) + (size_t)(1024 + n) * 512 + g * 128 + c0;
            *(u32x4*)dst = pack8(a);
        }
    }
    convert_weights(p, lds, 0, WI_IN, blockIdx.x * 8 + wid, gridDim.x * 8);
    {
        bf16_t* XB = (bf16_t*)(p.ws + WS_XB);
        const int gw = blockIdx.x * 8 + wid, NGW = gridDim.x * 8;
#pragma unroll 1
        for (int m0 = gw; m0 < MREAL; m0 += 4 * NGW) {
            f32x4 v[4][4];
#pragma unroll
            for (int r = 0; r < 4; ++r) { const int m = m0 + r * NGW;
                if (m < MREAL) { const f32x4* xr = (const f32x4*)(m < MP ? p.xp + (size_t)m * DM : p.xs + (size_t)(m - MP) * DM) + lane;
#pragma unroll
                    for (int j = 0; j < 4; ++j) v[r][j] = xr[64 * j]; } }
#pragma unroll
            for (int r = 0; r < 4; ++r) { const int m = m0 + r * NGW;
                if (m < MREAL) { float s = 0.f; u32x2* o8 = (u32x2*)(XB + (size_t)m * DM) + lane;
#pragma unroll
                    for (int j = 0; j < 4; ++j) { s += (v[r][j][0] * v[r][j][0] + v[r][j][1] * v[r][j][1]) + (v[r][j][2] * v[r][j][2] + v[r][j][3] * v[r][j][3]);
                        u32x2 w; w.x = cvt_pk_bf16(v[r][j][0], v[r][j][1]); w.y = cvt_pk_bf16(v[r][j][2], v[r][j][3]); o8[64 * j] = w; }
                    s = wave_sum(s);
                    if (lane == 0) ssq[m] = s; } }
        }
    }
}

#define XB_TMO      128
#define XB_XCNT(j)  (256  + 64 * (j))
#define XB_XSUB(j)  (1280 + 64 * (j))
#define XB_XGEN(j)  (2304 + 64 * (j))
#define XB_TOP      3328
#define XB_TOPGEN   3392
#define XCD_BAR_WORDS 3456
#define XB_SPIN_CAP (1u << 18)
__device__ __forceinline__ unsigned xb_ld(unsigned* p)              { return __hip_atomic_load(p, __ATOMIC_RELAXED, __HIP_MEMORY_SCOPE_AGENT); }
__device__ __forceinline__ unsigned xb_add(unsigned* p, unsigned v) { return __hip_atomic_fetch_add(p, v, __ATOMIC_RELAXED, __HIP_MEMORY_SCOPE_AGENT); }
__device__ __forceinline__ unsigned xb_xcc_id() { return (unsigned)__builtin_amdgcn_s_getreg((3 << 11) | 20) & 0xFu; }
#define XB_SPIN(cond, bar) do { unsigned _sp = 0; while (cond) { __builtin_amdgcn_s_sleep(1); \
    if ((++_sp & 255u) == 0u) { if (xb_ld(&(bar)[XB_TMO])) break; if (_sp > XB_SPIN_CAP) { atomicAdd(&(bar)[XB_TMO], 1u); break; } } } } while (0)
struct XcdBarrier { unsigned* bar; unsigned x; volatile LAS unsigned* st; };
__device__ __forceinline__ XcdBarrier xcd_barrier_post(unsigned* bar, volatile LAS unsigned* st) {
    XcdBarrier b; b.bar = bar; b.x = xb_xcc_id(); b.st = st;
    if (threadIdx.x == 0) (void)xb_add(&bar[XB_XCNT(b.x)], 1u);
    return b;
}
__device__ __forceinline__ void xcd_barrier_complete(unsigned* bar, unsigned x, unsigned& nloc, unsigned& nx) {
    const unsigned G = gridDim.x * gridDim.y * gridDim.z;
    unsigned sum, cnt, mine, sp = 0u;
    for (;;) {
        sum = 0u; cnt = 0u; mine = 0u;
#pragma unroll
        for (unsigned j = 0; j < 16; ++j) { const unsigned c = xb_ld(&bar[XB_XCNT(j)]); sum += c; cnt += (c > 0u) ? 1u : 0u; mine = (j == x) ? c : mine; }
        if (sum == G) break;
        __builtin_amdgcn_s_sleep(1);
        if ((++sp & 255u) == 0u) { if (xb_ld(&bar[XB_TMO])) break; if (sp > XB_SPIN_CAP) { atomicAdd(&bar[XB_TMO], 1u); break; } }
    }
    nloc = mine > 0u ? mine : 1u; nx = cnt > 0u ? cnt : 1u;
}
__device__ __forceinline__ void xcd_barrier(const XcdBarrier& b) {
    asm volatile("s_waitcnt vmcnt(0)" ::: "memory");
    __syncthreads();
    if (threadIdx.x == 0) {
        unsigned* bar = b.bar;
        __builtin_amdgcn_s_waitcnt(0);
        unsigned nloc = b.st[0], nx = b.st[1];
        if (nloc == 0u) { xcd_barrier_complete(bar, b.x, nloc, nx); b.st[0] = nloc; b.st[1] = nx; }
        const unsigned old = xb_add(&bar[XB_XSUB(b.x)], 1u);
        const unsigned gen = old / nloc;
        if (old + 1u == (gen + 1u) * nloc) {
            __builtin_amdgcn_fence(__ATOMIC_RELEASE, "agent");
            asm volatile("s_waitcnt vmcnt(0)" ::: "memory");
            const unsigned og = xb_add(&bar[XB_TOP], 1u);
            const unsigned tg = og / nx;
            if (og + 1u == (tg + 1u) * nx) xb_add(&bar[XB_TOPGEN], 1u);
            else XB_SPIN(xb_ld(&bar[XB_TOPGEN]) == tg, bar);
            __builtin_amdgcn_fence(__ATOMIC_ACQUIRE, "agent");
            xb_add(&bar[XB_XGEN(b.x)], 1u);
            asm volatile("s_waitcnt vmcnt(0)" ::: "memory");
        } else {
            XB_SPIN(xb_ld(&bar[XB_XGEN(b.x)]) == gen, bar);
            __builtin_amdgcn_fence(__ATOMIC_ACQUIRE, "agent");
            asm volatile("s_waitcnt vmcnt(0)" ::: "memory");
        }
    }
    __syncthreads();
}


__global__ void __launch_bounds__(512) mk_fwd(Params p0) {
    extern __shared__ __attribute__((aligned(16))) unsigned char lds_raw[];
    LAS unsigned char* lds = (LAS unsigned char*)lds_raw;
    cg::grid_group grid = cg::this_grid();
    const int G = gridDim.x, bx = blockIdx.x;

    if (threadIdx.x < 2) ((volatile LAS unsigned*)(lds + MISC_OFF))[threadIdx.x] = 0u;
    {
        unsigned* bar = (unsigned*)(p0.ws + WS_BAR); unsigned* ready = bar + 4096;
        if (bx == 0) {
            for (int i = threadIdx.x; i < XCD_BAR_WORDS; i += 512) __hip_atomic_store(bar + i, 0u, __ATOMIC_RELAXED, __HIP_MEMORY_SCOPE_AGENT);
            asm volatile("s_waitcnt vmcnt(0)" ::: "memory");
            __syncthreads();
            if (threadIdx.x == 0) { __builtin_amdgcn_fence(__ATOMIC_RELEASE, "agent"); __hip_atomic_store(ready, 0x13572468u, __ATOMIC_RELAXED, __HIP_MEMORY_SCOPE_AGENT); }
        } else {
            if (threadIdx.x == 0) { unsigned sp = 0; while (__hip_atomic_load(ready, __ATOMIC_RELAXED, __HIP_MEMORY_SCOPE_AGENT) != 0x13572468u && ++sp < (1u << 22)) __builtin_amdgcn_s_sleep(2);
                                    __builtin_amdgcn_fence(__ATOMIC_ACQUIRE, "agent"); }
        }
        __syncthreads();
    }
    const XcdBarrier xbar = xcd_barrier_post((unsigned*)(p0.ws + WS_BAR), (volatile LAS unsigned*)(lds + MISC_OFF));
    if (p0.ws == nullptr) grid.sync();
    for (int rep = 0; rep < REP_P0; ++rep) { prologue(p0, lds); xcd_barrier(xbar); }
    for (int rep = 0; rep < EXTRA_SYNC; ++rep) xcd_barrier(xbar);

#pragma unroll 1
    for (int l = 0; l < 2; ++l) {
        Params p = p0;
        { unsigned char* w_ = p0.ws; float* o_ = p0.out; asm volatile("" : "+s"(w_), "+s"(o_)); p.ws = w_; p.out = o_; }
        float* ssq = (float*)(p.ws + WS_SSQ);
        bf16_t* XB = (bf16_t*)(p.ws + WS_XB); bf16_t* AD = (bf16_t*)(p.ws + WS_AD); bf16_t* MIX = (bf16_t*)(p.ws + WS_MIX); bf16_t* PROJ = (bf16_t*)(p.ws + WS_PROJ); bf16_t* U = PROJ;
        const unsigned char* wb = p.ws + WS_W + (size_t)l * W_LAYER;
        for (int rep = 0; rep < REP_P1; ++rep) {
            pg8::Gemm g{XB, (const bf16_t*)(wb + WO_IN), DM, DM, DM};
            small_proj(p, l, G, bx);
            SchedPlain S; S.o.init(MP / 256, INW / 256, G, bx); S.tA = 256L * DM * 2; S.tB = 256L * DM * 2;
            EpiProj E{PROJ, ssq + (2 * l) * MPAD, p.gate_bias + l * 2048};
            pg8::gemm_phase(lds, g, S, E);
            if (l == 0) convert_weights_idle(p, lds, WI_IN, WI_L, (MP / 256) * (INW / 256), G, bx);
        }
        xcd_barrier(xbar);
        for (int rep = 0; rep < REP_P2; ++rep) {
            const int vcu = (G % 8 == 0) ? (bx % 8) * (G / 8) + bx / 8 : bx;
#pragma unroll 1
            for (int idx = vcu; idx < 16 + 256; idx += G) {
                if (idx < 16) attn_unit(p, l, lds, true, idx >> 1, 0, idx & 1);
                else { const int q = idx - 16; attn_macro(p, l, lds, q >> 7, q & 63, (q >> 6) & 1); }
            }
            if (l == 0 && (vcu >= 16 || G <= 16)) { int tid_ = threadIdx.x; asm volatile("" : "+v"(tid_));
                const int nw = G > 16 ? G - 16 : G; convert_weights(p, lds, WI_L, 2 * WI_L, ((G > 16 ? vcu - 16 : vcu) * 8) + __builtin_amdgcn_readfirstlane(tid_ >> 6), nw * 8); }
        }
        xcd_barrier(xbar);
        for (int rep = 0; rep < REP_P3; ++rep) {
            pg8::Gemm g{AD, (const bf16_t*)(wb + WO_MIX), DM, 512, 512};
            small_mix(p, l, lds, G, bx);
            SchedMix S; S.o.init(MP / 256, DM / 256, G, bx);
            EpiMix E{MIX, PROJ};
            pg8::gemm_phase(lds, g, S, E);
        }
        xcd_barrier(xbar);
        {
            pg8::Gemm g{MIX, (const bf16_t*)(wb + WO_OUT), DM, DM, DM};
            SchedPlain S; S.o.init(MP / 256, DM / 256, G, bx); S.tA = 256L * DM * 2; S.tB = 256L * DM * 2;
            if (l == 0) { small_res<true, false, 4>(p, lds, MIX, DM, (const bf16_t*)(wb + WO_OUT), DM, ssq + (2 * l + 1) * MPAD, G, bx);
                          EpiRes<true, false> E{p.xp, p.out, XB, ssq + (2 * l + 1) * MPAD}; pg8::gemm_phase(lds, g, S, E); }
            else        { small_res<false, false, 4>(p, lds, MIX, DM, (const bf16_t*)(wb + WO_OUT), DM, ssq + (2 * l + 1) * MPAD, G, bx);
                          EpiRes<false, false> E{p.xp, p.out, XB, ssq + (2 * l + 1) * MPAD}; pg8::gemm_phase(lds, g, S, E); }
        }
        xcd_barrier(xbar);
        for (int rep = 0; rep < REP_P5; ++rep) {
            pg8::Gemm g{XB, (const bf16_t*)(wb + WO_UP), DM, DM, DM};
            small_up(p, l, lds, G, bx);
            SchedPlain S; S.o.init(MP / 256, FF2 / 256, G, bx); S.tA = 256L * DM * 2; S.tB = 256L * DM * 2;
            EpiUpConv E{U, ssq + (2 * l + 1) * MPAD, p.conv_w + (size_t)l * 3 * FF2, p.conv_b + (size_t)l * FF2, p.out + O_CP + (size_t)l * 2 * 2 * FF2, (LAS float*)(lds + XCH_OFF), (float*)(p.ws + WS_HALO)};
            pg8::gemm_phase(lds, g, S, E);
        }
        xcd_barrier(xbar);
        {
            pg8::Gemm g{U, (const bf16_t*)(wb + WO_DOWN), FF, FF, FF};
            SchedPlain S; S.o.init(MP / 256, DM / 256, G, bx); S.tA = 256L * FF * 2; S.tB = 256L * FF * 2;
            { Unit u0, u1; const bool h0 = S.next(0, u0), h1 = S.next(1, u1);
              if (h0) conv_fixup2(p, l, u0.pm, h1 ? u1.pm : u0.pm);
              Unit uu; for (int i = 2; S.next(i, uu); ++i) conv_fixup(p, l, uu.pm);
              asm volatile("s_waitcnt vmcnt(0)" ::: "memory"); __syncthreads(); }
            for (int rep = 0; rep < DRY_P6; ++rep) { EpiNone E0{ssq}; pg8::gemm_phase(lds, g, S, E0); }
            if (l == 0) { small_res<false, false, 11>(p, lds, U, FF, (const bf16_t*)(wb + WO_DOWN), FF, ssq + 2 * MPAD, G, bx);
                          EpiRes<false, false> E{p.xp, p.out, XB, ssq + 2 * MPAD}; pg8::gemm_phase(lds, g, S, E); }
            else        { small_res<false, true, 11>(p, lds, U, FF, (const bf16_t*)(wb + WO_DOWN), FF, nullptr, G, bx);
                          EpiRes<false, true> E{p.xp, p.out, XB, nullptr}; pg8::gemm_phase(lds, g, S, E); }
        }
        if (l == 0) xcd_barrier(xbar);
    }
    if (bx == 0 && threadIdx.x == 0) __hip_atomic_store((unsigned*)(p0.ws + WS_BAR) + 4096, 0u, __ATOMIC_RELAXED, __HIP_MEMORY_SCOPE_AGENT);
}

extern "C" void kernel_launch(void* const* d_in, const int* in_sizes, int n_in, void* d_out, int out_size, void* d_ws, size_t ws_size, hipStream_t stream) {
    static int grid_blocks = 0;
    if (!grid_blocks) {
        int dev = 0, cus = 0, per_cu = 0;
        hipGetDevice(&dev);
        hipDeviceGetAttribute(&cus, hipDeviceAttributeMultiprocessorCount, dev);
        hipFuncSetAttribute((const void*)mk_fwd, hipFuncAttributeMaxDynamicSharedMemorySize, LDS_BYTES);
        hipOccupancyMaxActiveBlocksPerMultiprocessor(&per_cu, (const void*)mk_fwd, 512, LDS_BYTES);
        if (per_cu < 1) { fprintf(stderr, "kernel_launch: occupancy query reports %d blocks per CU\n", per_cu); per_cu = 1; }
        if (per_cu > 1) per_cu = 1;
        grid_blocks = cus * per_cu;
    }
    Params p{};
    const float** pp = (const float**)&p;
    for (int i = 0; i < 22; ++i) pp[i] = (const float*)d_in[i];
    p.out = (float*)d_out; p.ws = (unsigned char*)d_ws;
    void* args[] = {&p};
    hipError_t e = hipLaunchCooperativeKernel((const void*)mk_fwd, dim3(grid_blocks), dim3(512), args, LDS_BYTES, stream);
    if (e != hipSuccess) fprintf(stderr, "cooperative launch failed: %s (grid %d)\n", hipGetErrorString(e), grid_blocks);
}
```
